# Optimizing an MI355X kernel written in HIP

```python
import math
import jax, jax.numpy as jnp
from jax import lax
import numpy as np

D_MODEL = 1024
BATCH = 2
SEQ = 8192
DEPTH = 2

D_FF = 2816
EPS = 1e-6
Q_BLOCK = 128
NEG_INF = -1e30

MLA_HEADS = 8
MLA_NOPE_DIM = 64
MLA_ROPE_DIM = 32
MLA_V_DIM = 64
MLA_Q_RANK = 256
MLA_KV_RANK = 128
ROPE_BASE = 10000.0

DIFF_HEADS = 8
DIFF_HEAD_DIM = 32

POOL_WINDOWS = (2, 4, 8, 16)
POOL_GROUP = 128
POOL_WIDTH = POOL_GROUP * len(POOL_WINDOWS)

N_BRANCH = 3
BRANCH_WIDTH = 512

DIFF_QK = DIFF_HEADS * 2 * DIFF_HEAD_DIM
DIFF_V = DIFF_HEADS * 2 * DIFF_HEAD_DIM
GATE_WIDTH = N_BRANCH * D_MODEL
IN_SPLITS = (MLA_Q_RANK, MLA_KV_RANK, MLA_ROPE_DIM, DIFF_QK, DIFF_QK, DIFF_V, POOL_WIDTH, GATE_WIDTH)
IN_WIDTH = sum(IN_SPLITS)

kernel_name = "hybrid_mla_diffattn_pool_macaron"


def rmsnorm(x, g):
    xf = x.astype(jnp.float32)
    y = xf * lax.rsqrt(jnp.mean(xf * xf, axis=-1, keepdims=True) + EPS)
    return (y * g.astype(jnp.float32)).astype(x.dtype)


def swiglu(x, w_gate, w_up, w_down):
    return (jax.nn.silu(x @ w_gate) * (x @ w_up)) @ w_down


def rope(x, pos):
    half = x.shape[-1] // 2
    inv_freq = ROPE_BASE ** (-jnp.arange(half, dtype=jnp.float32) / half)
    ang = pos.astype(jnp.float32)[:, :, None, None] * inv_freq
    cos, sin = jnp.cos(ang), jnp.sin(ang)
    xf = x.astype(jnp.float32)
    x1, x2 = xf[..., :half], xf[..., half:]
    return jnp.concatenate([x1 * cos - x2 * sin, x2 * cos + x1 * sin], axis=-1).astype(x.dtype)


def sweep_query_blocks(fn, *qs):
    b, s = qs[0].shape[:2]
    nb = s // Q_BLOCK
    blocked = tuple(jnp.moveaxis(q.reshape((b, nb, Q_BLOCK) + q.shape[2:]), 1, 0) for q in qs)
    starts = jnp.arange(nb, dtype=jnp.int32) * Q_BLOCK
    out = lax.map(lambda a: fn(a[0], *a[1]), (starts, blocked))
    out = jnp.moveaxis(out, 0, 1)
    return out.reshape((b, s) + out.shape[3:])


def causal_mask(start, s):
    q_idx = start + jnp.arange(Q_BLOCK, dtype=jnp.int32)
    k_idx = jnp.arange(s, dtype=jnp.int32)
    return k_idx[None, :] <= q_idx[:, None]


def mla_mixer(c_q, c_kv, k_rope_raw, pos, q_norm, w_uq, kv_norm, w_ukv):
    b, s, _ = c_q.shape
    q = (rmsnorm(c_q, q_norm) @ w_uq).reshape(b, s, MLA_HEADS, MLA_NOPE_DIM + MLA_ROPE_DIM)
    q_nope, q_rope = q[..., :MLA_NOPE_DIM], rope(q[..., MLA_NOPE_DIM:], pos)
    kv = (rmsnorm(c_kv, kv_norm) @ w_ukv).reshape(b, s, MLA_HEADS, MLA_NOPE_DIM + MLA_V_DIM)
    k_nope, v = kv[..., :MLA_NOPE_DIM], kv[..., MLA_NOPE_DIM:]
    k_rope = rope(k_rope_raw[:, :, None, :], pos)[:, :, 0]
    scale = (MLA_NOPE_DIM + MLA_ROPE_DIM) ** -0.5

    def block(start, qn, qr):
        sc = jnp.einsum('bqhd,bkhd->bhqk', qn, k_nope) + jnp.einsum('bqhd,bkd->bhqk', qr, k_rope)
        sc = jnp.where(causal_mask(start, s), sc.astype(jnp.float32) * scale, NEG_INF)
        p = jax.nn.softmax(sc, axis=-1).astype(v.dtype)
        return jnp.einsum('bhqk,bkhd->bqhd', p, v)

    o = sweep_query_blocks(block, q_nope, q_rope)
    return o.reshape(b, s, MLA_HEADS * MLA_V_DIM)


def diff_mixer(q, k, v, pos, lq1, lk1, lq2, lk2, subln, lambda_init):
    b, s, _ = q.shape
    q = q.reshape(b, s, DIFF_HEADS, 2, DIFF_HEAD_DIM)
    k = k.reshape(b, s, DIFF_HEADS, 2, DIFF_HEAD_DIM)
    v = v.reshape(b, s, DIFF_HEADS, 2 * DIFF_HEAD_DIM)
    f32 = jnp.float32
    lam = (jnp.exp(jnp.sum(lq1.astype(f32) * lk1.astype(f32)))
           - jnp.exp(jnp.sum(lq2.astype(f32) * lk2.astype(f32))) + lambda_init)
    slopes = jnp.exp2(-8.0 * jnp.arange(1, DIFF_HEADS + 1, dtype=f32) / DIFF_HEADS)
    scale = DIFF_HEAD_DIM ** -0.5

    def block(start, qb, pb):
        sc = jnp.einsum('bqhmd,bkhmd->bmhqk', qb, k).astype(f32) * scale
        dist = jnp.abs(pb[:, :, None] - pos[:, None, :]).astype(f32)
        sc = sc - slopes[None, None, :, None, None] * dist[:, None, None]
        sc = jnp.where(causal_mask(start, s), sc, NEG_INF)
        p = jax.nn.softmax(sc, axis=-1)
        a = (p[:, 0] - lam * p[:, 1]).astype(v.dtype)
        return jnp.einsum('bhqk,bkhd->bqhd', a, v)

    o = sweep_query_blocks(block, q, pos)
    o = rmsnorm(o, subln) * (1.0 - lambda_init)
    return o.reshape(b, s, DIFF_HEADS * 2 * DIFF_HEAD_DIM)


def pool_mixer(p, pool_w, pool_b, pool_scale):
    b, s, _ = p.shape
    pf = p.astype(jnp.float32)
    cs = jnp.cumsum(pf, axis=1)
    t = jnp.arange(s, dtype=jnp.int32)
    outs = []
    for g, w in enumerate(POOL_WINDOWS):
        sl = slice(g * POOL_GROUP, (g + 1) * POOL_GROUP)
        c = cs[..., sl]
        prev = jnp.pad(c, ((0, 0), (w, 0), (0, 0)))[:, :s]
        cnt = jnp.minimum(t + 1, w).astype(jnp.float32)[None, :, None]
        outs.append((c - prev) / cnt - pf[..., sl])
    pooled = jnp.stack(outs, axis=2).astype(p.dtype)
    y = jnp.einsum('bsgc,gcd->bsgd', pooled, pool_w) + pool_b
    return y.reshape(b, s, POOL_WIDTH) * pool_scale


def setup_inputs(seed: int = 0) -> dict:
    key = jax.random.key(seed)
    ks = iter(jax.random.split(key, 40))
    f32 = jnp.float32

    def dense(shape, fan_in):
        return jax.random.normal(next(ks), shape, f32) * fan_in ** -0.5

    def gain(shape):
        return 1.0 + 0.02 * jax.random.normal(next(ks), shape, f32)

    x = jax.random.normal(next(ks), (BATCH, SEQ, D_MODEL), f32)
    offset = jax.random.randint(next(ks), (BATCH, 1), 0, 1024, dtype=jnp.int32)
    positions = (jnp.arange(SEQ, dtype=jnp.int32)[None, :] + offset).astype(jnp.int32)
    return {
        "x": x,
        "positions": positions,
        "ffn1_norm": gain((DEPTH, D_MODEL)),
        "ffn1_w_gate": dense((DEPTH, D_MODEL, D_FF), D_MODEL),
        "ffn1_w_up": dense((DEPTH, D_MODEL, D_FF), D_MODEL),
        "ffn1_w_down": dense((DEPTH, D_FF, D_MODEL), D_FF),
        "mix_norm": gain((DEPTH, D_MODEL)),
        "w_in": dense((DEPTH, D_MODEL, IN_WIDTH), D_MODEL),
        "mla_q_norm": gain((DEPTH, MLA_Q_RANK)),
        "mla_w_uq": dense((DEPTH, MLA_Q_RANK, MLA_HEADS * (MLA_NOPE_DIM + MLA_ROPE_DIM)), MLA_Q_RANK),
        "mla_kv_norm": gain((DEPTH, MLA_KV_RANK)),
        "mla_w_ukv": dense((DEPTH, MLA_KV_RANK, MLA_HEADS * (MLA_NOPE_DIM + MLA_V_DIM)), MLA_KV_RANK),
        "diff_lambda_q1": 0.1 * jax.random.normal(next(ks), (DEPTH, DIFF_HEAD_DIM), f32),
        "diff_lambda_k1": 0.1 * jax.random.normal(next(ks), (DEPTH, DIFF_HEAD_DIM), f32),
        "diff_lambda_q2": 0.1 * jax.random.normal(next(ks), (DEPTH, DIFF_HEAD_DIM), f32),
        "diff_lambda_k2": 0.1 * jax.random.normal(next(ks), (DEPTH, DIFF_HEAD_DIM), f32),
        "diff_subln": gain((DEPTH, 2 * DIFF_HEAD_DIM)),
        "pool_w": dense((DEPTH, len(POOL_WINDOWS), POOL_GROUP, POOL_GROUP), POOL_GROUP),
        "pool_b": 0.01 * jax.random.normal(next(ks), (DEPTH, len(POOL_WINDOWS), POOL_GROUP), f32),
        "pool_scale": 1.0 + 0.05 * jax.random.normal(next(ks), (DEPTH, POOL_WIDTH), f32),
        "w_branch": dense((DEPTH, N_BRANCH, BRANCH_WIDTH, D_MODEL), BRANCH_WIDTH),
        "w_out": dense((DEPTH, D_MODEL, D_MODEL), D_MODEL),
        "ffn2_norm": gain((DEPTH, D_MODEL)),
        "ffn2_w_gate": dense((DEPTH, D_MODEL, D_FF), D_MODEL),
        "ffn2_w_up": dense((DEPTH, D_MODEL, D_FF), D_MODEL),
        "ffn2_w_down": dense((DEPTH, D_FF, D_MODEL), D_FF),
        "final_norm": gain((D_MODEL,)),
    }


def reference(x, positions, ffn1_norm, ffn1_w_gate, ffn1_w_up, ffn1_w_down, mix_norm, w_in,
              mla_q_norm, mla_w_uq, mla_kv_norm, mla_w_ukv,
              diff_lambda_q1, diff_lambda_k1, diff_lambda_q2, diff_lambda_k2, diff_subln,
              pool_w, pool_b, pool_scale, w_branch, w_out,
              ffn2_norm, ffn2_w_gate, ffn2_w_up, ffn2_w_down, final_norm):
    b, s, d = x.shape
    split_idx = [int(v) for v in np.cumsum(IN_SPLITS)[:-1]]
    h = x
    for l in range(DEPTH):
        h = h + 0.5 * swiglu(rmsnorm(h, ffn1_norm[l]), ffn1_w_gate[l], ffn1_w_up[l], ffn1_w_down[l])

        u = rmsnorm(h, mix_norm[l])
        z = u @ w_in[l]
        c_q, c_kv, k_rope, dq, dk, dv, p_in, z_gate = jnp.split(z, split_idx, axis=-1)

        y_mla = mla_mixer(c_q, c_kv, k_rope, positions,
                          mla_q_norm[l], mla_w_uq[l], mla_kv_norm[l], mla_w_ukv[l])
        lambda_init = 0.8 - 0.6 * math.exp(-0.3 * l)
        y_diff = diff_mixer(dq, dk, dv, positions, diff_lambda_q1[l], diff_lambda_k1[l],
                            diff_lambda_q2[l], diff_lambda_k2[l], diff_subln[l], lambda_init)
        y_pool = pool_mixer(p_in, pool_w[l], pool_b[l], pool_scale[l])

        branches = jnp.stack([y_mla, y_diff, y_pool], axis=2)
        branches = jnp.einsum('bsnc,ncd->bsnd', branches, w_branch[l])
        gates = jax.nn.sigmoid(z_gate.reshape(b, s, N_BRANCH, d))
        merged = jnp.sum(gates * branches, axis=2)
        h = h + merged @ w_out[l]

        h = h + 0.5 * swiglu(rmsnorm(h, ffn2_norm[l]), ffn2_w_gate[l], ffn2_w_up[l], ffn2_w_down[l])
    return rmsnorm(h, final_norm)
```

```cpp
#include <hip/hip_runtime.h>
#include <hip/hip_cooperative_groups.h>
#include <cstdio>
#include <cstdint>
#include <cmath>
namespace cg = cooperative_groups;
namespace pg8 {
#define PG8_LAS __attribute__((address_space(3)))
typedef unsigned short bf16_t;
typedef short bf16x8 __attribute__((ext_vector_type(8)));
typedef float f32x4 __attribute__((ext_vector_type(4)));
typedef unsigned u32x4 __attribute__((ext_vector_type(4)));
constexpr int BM = 256, BK = 64, HALF = 128, HTB = HALF * BK * 2  , STAGE_BYTES = 8 * HTB, NXCD = 8, WGM = 8;

__host__ __device__ __forceinline__ int lds_byte(int r, int c) { const int st = (r >> 4) * 2 + (c >> 5), rr = r & 15, cc = c & 31, ob = rr * 64 + cc * 2; return st * 1024 + (ob ^ (((ob >> 9) & 1) << 5)); }
__host__ __device__ __forceinline__ void stage_rc(int b, int& R, int& C) { const int st = b / 1024, sb = b % 1024, swz = sb ^ (((sb >> 9) & 1) << 5); R = (st >> 1) * 16 + swz / 64; C = (st & 1) * 32 + (swz % 64) / 2; }
__host__ __device__ __forceinline__ int perm32(int rho) { const int n = rho >> 4, i = rho & 15; return 8 * (i >> 2) + 4 * n + (i & 3); }

struct Unit { int pm, pn; };
struct Gemm { const bf16_t* A; const bf16_t* Bt; int M, N, K; };

struct StaticOrder {
    int nM, nN, nwg, G, c;
    __host__ __device__ void init(int M, int N, int G_, int c_) { nM = M / BM; nN = N / BM; nwg = nM * nN; G = G_; c = c_; }
    __host__ __device__ bool next(int i, Unit& u) const {
        const long L = (long)i * G + c; if (L >= nwg) return false;
        int wgid = (int)L; { const int q = nwg / NXCD, r = nwg % NXCD, xcd = wgid % NXCD, off = wgid / NXCD; wgid = (xcd < r ? xcd * (q + 1) : r * (q + 1) + (xcd - r) * q) + off; }
        const int nig = WGM * nN, gid = wgid / nig, fm = gid * WGM, gsz = (nM - fm) < WGM ? (nM - fm) : WGM;
        u.pm = fm + ((wgid % nig) % gsz); u.pn = (wgid % nig) / gsz; return true;
    }
    __device__ __forceinline__ void a_ready(const Unit&) const {}
    __device__ __forceinline__ void done(const Unit&) const {}
};

typedef float f32x2_cv __attribute__((ext_vector_type(2))); typedef __bf16 bf16x2_cv __attribute__((ext_vector_type(2)));
__device__ __forceinline__ unsigned cvt_pk_bf16(float lo, float hi) { f32x2_cv v = {lo, hi}; bf16x2_cv b = __builtin_convertvector(v, bf16x2_cv); return __builtin_bit_cast(unsigned, b); }
typedef float f32x2 __attribute__((ext_vector_type(2)));
typedef unsigned u32x2 __attribute__((ext_vector_type(2)));
constexpr float RMS_EPS = 1e-6f;
__device__ __forceinline__ float sigmoid_f(float x) { return __builtin_amdgcn_rcpf(1.f + __builtin_amdgcn_exp2f(-1.4426950408889634f * x)); }
__device__ __forceinline__ float row_ssq(const float* ssq, int r) { const f32x4* p = (const f32x4*)(ssq + (unsigned)(r * 16)); const f32x4 a = p[0], b = p[1], c = p[2], d = p[3];
    return ((a[0] + a[1]) + (a[2] + a[3])) + ((b[0] + b[1]) + (b[2] + b[3])) + ((c[0] + c[1]) + (c[2] + c[3])) + ((d[0] + d[1]) + (d[2] + d[3])); }
__device__ __forceinline__ float bf_lo(unsigned u) { return __uint_as_float(u << 16); }
__device__ __forceinline__ float bf_hi(unsigned u) { return __uint_as_float(u & 0xffff0000u); }
__device__ __forceinline__ u32x4 pack8(const f32x4 v0, const f32x4 v1) { u32x4 w; w.x = cvt_pk_bf16(v0[0], v0[1]); w.y = cvt_pk_bf16(v0[2], v0[3]); w.z = cvt_pk_bf16(v1[0], v1[1]); w.w = cvt_pk_bf16(v1[2], v1[3]); return w; }
template <int MODE> struct Epi {
    static constexpr bool PERM = true, AFTER_DRAIN = false;
    bf16_t* O; int ldc; bf16_t* O2; int ldc2; int split;
    const float* ssq; float inv_n;
    const float* base; float* outf; float alpha; float* ssq_out;
    const float* bias; const float* scale;
    const bf16_t* G; int first;
    __device__ __forceinline__ void operator()(const f32x4 (&acc)[2][2][4][2], const Unit& u, int wr, int wc, int fr, int fq) const {
        bf16_t* O = this->O; bf16_t* O2 = this->O2; const float* ssq = this->ssq; const float* base = this->base; float* outf = this->outf; float* ssq_out = this->ssq_out;
        const float* bias = this->bias; const float* scale = this->scale; const bf16_t* G = this->G; unsigned alpha_u = __float_as_uint(this->alpha), inv_u = __float_as_uint(this->inv_n);
        asm volatile("" : "+s"(O), "+s"(O2), "+s"(ssq), "+s"(base), "+s"(outf), "+s"(ssq_out));
        asm volatile("" : "+s"(bias), "+s"(scale), "+s"(G), "+s"(alpha_u), "+s"(inv_u));
        const float alpha = __uint_as_float(alpha_u), inv_n = __uint_as_float(inv_u);
        { int t_ = threadIdx.x; asm volatile("" : "+v"(t_)); fr = t_ & 15; fq = (t_ >> 4) & 3; }
        const int row0 = u.pm * BM + wr * 64 + fr;
        if constexpr (MODE == 1) {
            const int col0 = u.pn * HALF + wc * 32 + 8 * fq;
#pragma unroll
            for (int ai = 0; ai < 2; ++ai)
#pragma unroll
                for (int m = 0; m < 4; ++m) { const int r = row0 + ai * HALF + m * 16; const float sc = __builtin_amdgcn_rsqf(row_ssq(ssq, r) * inv_n + RMS_EPS);
                    f32x4 o[2];
#pragma unroll
                    for (int n = 0; n < 2; ++n)
#pragma unroll
                        for (int e = 0; e < 4; ++e) { const float g = acc[ai][0][m][n][e] * sc, uu = acc[ai][1][m][n][e] * sc; o[n][e] = g * sigmoid_f(g) * uu; }
                    *(u32x4*)(O + (unsigned)(r * ldc + col0)) = pack8(o[0], o[1]); }
        } else if constexpr (MODE == 2) {
#pragma unroll
            for (int ai = 0; ai < 2; ++ai)
#pragma unroll
                for (int m = 0; m < 4; ++m) { const int r = row0 + ai * HALF + m * 16; float s = 0.f;
#pragma unroll
                    for (int bj = 0; bj < 2; ++bj) { const unsigned off = (unsigned)(r * 1024 + u.pn * BM + bj * HALF + wc * 32 + 8 * fq);
                        const f32x4 b0 = *(const f32x4*)(base + off), b1 = *(const f32x4*)(base + off + 4);
                        const f32x4 h0 = b0 + acc[ai][bj][m][0] * alpha, h1 = b1 + acc[ai][bj][m][1] * alpha;
                        *(f32x4*)(outf + off) = h0; *(f32x4*)(outf + off + 4) = h1;
                        if (O != nullptr) *(u32x4*)(O + off) = pack8(h0, h1);
                        s += (h0[0] * h0[0] + h0[1] * h0[1]) + (h0[2] * h0[2] + h0[3] * h0[3]) + (h1[0] * h1[0] + h1[1] * h1[1]) + (h1[2] * h1[2] + h1[3] * h1[3]); }
                    s += __shfl_xor(s, 16); s += __shfl_xor(s, 32);
                    if (fq == 0) ssq_out[(unsigned)(r * 16 + u.pn * 4 + wc)] = s;
                    asm volatile("" ::: "memory"); }
        } else if constexpr (MODE == 7) {
#pragma unroll
            for (int ai = 0; ai < 2; ++ai)
#pragma unroll
                for (int m = 0; m < 4; ++m) { const int r = row0 + ai * HALF + m * 16;
#pragma unroll
                    for (int bj = 0; bj < 2; ++bj) { const int hh = 2 * u.pn + bj; const f32x4 v0 = acc[ai][bj][m][0], v1 = acc[ai][bj][m][1];
                        if (wc < 2) *(u32x4*)(O + (unsigned)(r * 512 + hh * 64 + wc * 32 + 8 * fq)) = pack8(v0, v1);
                        else { bf16_t* vt = O2 + (unsigned)((((r >> 13) * 8 + hh) * 64 + (wc - 2) * 32 + 8 * fq) * 8192 + (r & 8191));
#pragma unroll
                            for (int e = 0; e < 4; ++e) { vt[(unsigned)(e * 8192)] = (bf16_t)(cvt_pk_bf16(v0[e], 0.f) & 0xffffu); vt[(unsigned)((4 + e) * 8192)] = (bf16_t)(cvt_pk_bf16(v1[e], 0.f) & 0xffffu); } } } }
        } else {
            int colt = u.pn * BM; bf16_t* ob = O; int ld = ldc;
            if (MODE == 0 && colt >= split) { ob = O2; ld = ldc2; colt -= split; }
            if (MODE == 0 && colt >= 1024) {
                bf16_t* VT = (bf16_t*)G;
#pragma unroll
                for (int ai = 0; ai < 2; ++ai)
#pragma unroll
                    for (int m = 0; m < 4; ++m) { const int r = row0 + ai * HALF + m * 16; const float sc = __builtin_amdgcn_rsqf(row_ssq(ssq, r) * inv_n + RMS_EPS);
#pragma unroll
                        for (int bj = 0; bj < 2; ++bj) { const f32x4 v0 = acc[ai][bj][m][0] * sc, v1 = acc[ai][bj][m][1] * sc;
                            bf16_t* vt = VT + (unsigned)(((r >> 13) * 512 + (colt - 1024) + bj * HALF + wc * 32 + 8 * fq) * 8192 + (r & 8191));
#pragma unroll
                            for (int e = 0; e < 4; ++e) { vt[(unsigned)(e * 8192)] = (bf16_t)(cvt_pk_bf16(v0[e], 0.f) & 0xffffu); vt[(unsigned)((4 + e) * 8192)] = (bf16_t)(cvt_pk_bf16(v1[e], 0.f) & 0xffffu); } } }
                return;
            }
            const int col0 = colt + wc * 32 + 8 * fq, gcol0 = u.pn * BM + wc * 32 + 8 * fq;
            f32x4 bv[2][2], sv[2][2];
            if constexpr (MODE == 3) {
#pragma unroll
                for (int bj = 0; bj < 2; ++bj)
#pragma unroll
                    for (int n = 0; n < 2; ++n) { bv[bj][n] = *(const f32x4*)(bias + gcol0 + bj * HALF + 4 * n); sv[bj][n] = *(const f32x4*)(scale + gcol0 + bj * HALF + 4 * n); }
            }
#pragma unroll
            for (int ai = 0; ai < 2; ++ai)
#pragma unroll
                for (int m = 0; m < 4; ++m) { const int r = row0 + ai * HALF + m * 16;
                    float sc = 1.f; if (MODE == 0 || MODE == 4) sc = __builtin_amdgcn_rsqf(row_ssq(ssq, r) * inv_n + RMS_EPS);
#pragma unroll
                    for (int bj = 0; bj < 2; ++bj) { f32x4 v0 = acc[ai][bj][m][0], v1 = acc[ai][bj][m][1]; bf16_t* p = ob + (unsigned)(r * ld + col0 + bj * HALF);
                        if constexpr (MODE == 0) { v0 = v0 * sc; v1 = v1 * sc; }
                        if constexpr (MODE == 3) { v0 = (v0 + bv[bj][0]) * sv[bj][0]; v1 = (v1 + bv[bj][1]) * sv[bj][1]; }
                        if constexpr (MODE == 4) {
#pragma unroll
                            for (int e = 0; e < 4; ++e) { v0[e] = sigmoid_f(v0[e] * sc); v1[e] = sigmoid_f(v1[e] * sc); } }
                        if constexpr (MODE == 5) { const u32x4 g = *(const u32x4*)(G + (unsigned)(r * ld + col0 + bj * HALF));
                            v0 = v0 * (f32x4){bf_lo(g.x), bf_hi(g.x), bf_lo(g.y), bf_hi(g.y)}; v1 = v1 * (f32x4){bf_lo(g.z), bf_hi(g.z), bf_lo(g.w), bf_hi(g.w)};
                            if (!first) { const u32x4 q = *(const u32x4*)p; v0 = v0 + (f32x4){bf_lo(q.x), bf_hi(q.x), bf_lo(q.y), bf_hi(q.y)}; v1 = v1 + (f32x4){bf_lo(q.z), bf_hi(q.z), bf_lo(q.w), bf_hi(q.w)}; } }
                        *(u32x4*)p = pack8(v0, v1); }
                    if (MODE == 5 || MODE == 4) asm volatile("" ::: "memory"); }
        }
    }
};
template <class Epi, class Sched, bool ALIGN_EPI = false, bool SP2 = false>
__device__ __forceinline__ void gemm_phase(PG8_LAS unsigned char* lds, const Gemm g, const Sched& S, const Epi& E) {
    int tid_l = threadIdx.x; asm volatile("" : "+v"(tid_l));
    const int tid = tid_l, wid = __builtin_amdgcn_readfirstlane(tid >> 6), lane = tid & 63, wr = wid >> 2, wc = wid & 3, fr = lane & 15, fq = lane >> 4;
    const int K = g.K, nt = K / BK;
    unsigned voffA[2], voffB[2];
#pragma unroll
    for (int i = 0; i < 2; ++i) { int R, C; stage_rc(tid * 16 + i * 8192, R, C); const int Rb = Epi::PERM ? ((R & ~31) + perm32(R & 31)) : R;
        voffA[i] = (unsigned)(R * K + C) * 2u; voffB[i] = (unsigned)(Rb * K + C) * 2u; }
    const size_t kstep = (size_t)(BK * 2);
    const size_t hstep = (size_t)HALF * K * 2;
    const size_t tstep = 2 * hstep;
    const unsigned ldsw = (unsigned)wid * 1024u;
    const int aoff = lds_byte(wr * 64 + fr, fq * 8), boff = lds_byte(wc * 32 + fr, fq * 8);
#define PG8_SA(b, h) (((b) * 2 + (h)) * HTB)
#define PG8_SB(b, h) ((4 + (b) * 2 + (h)) * HTB)
#define PG8_STAGE(bufoff, gbase, voff) do { _Pragma("unroll") for (int _i = 0; _i < 2; ++_i) \
        __builtin_amdgcn_global_load_lds((const unsigned*)((const char*)(gbase) + (voff)[_i]), (PG8_LAS unsigned*)(lds + (bufoff) + ldsw + _i * 8192), 16, 0, 0); } while (0)
#define PG8_LDA(dst, b, h) do { _Pragma("unroll") for (int m = 0; m < 4; ++m) _Pragma("unroll") for (int k = 0; k < 2; ++k) dst[m][k] = *(const PG8_LAS bf16x8*)(lds + PG8_SA(b, h) + aoff + m * 2048 + k * 1024); } while (0)
#define PG8_LDB(dst, b, h) do { _Pragma("unroll") for (int n = 0; n < 2; ++n) _Pragma("unroll") for (int k = 0; k < 2; ++k) dst[n][k] = *(const PG8_LAS bf16x8*)(lds + PG8_SB(b, h) + boff + n * 2048 + k * 1024); } while (0)
#define PG8_MMA(ai, bj, At, Bt) do { __builtin_amdgcn_s_setprio(1); _Pragma("unroll") for (int m = 0; m < 4; ++m) _Pragma("unroll") for (int n = 0; n < 2; ++n) _Pragma("unroll") for (int k = 0; k < 2; ++k) \
        acc[ai][bj][m][n] = __builtin_amdgcn_mfma_f32_16x16x32_bf16(Bt[n][k], At[m][k], acc[ai][bj][m][n], 0, 0, 0); __builtin_amdgcn_s_setprio(0); } while (0)
#define PG8_WAIT_V(n) asm volatile("s_waitcnt vmcnt(" #n ")" ::: "memory")
#define PG8_WAIT_L(n) asm volatile("s_waitcnt lgkmcnt(" #n ")" ::: "memory")
#define PG8_BAR __builtin_amdgcn_s_barrier()
#define PG8_SCHED __builtin_amdgcn_sched_barrier(0)
    Unit cur, nxt; int ui = 0;
    if (!S.next(0, cur)) return;
    f32x4 acc[2][2][4][2];
#pragma unroll
    for (int a = 0; a < 2; ++a)
#pragma unroll
        for (int b = 0; b < 2; ++b)
#pragma unroll
            for (int m = 0; m < 4; ++m)
#pragma unroll
                for (int n = 0; n < 2; ++n) acc[a][b][m][n] = (f32x4){0.f, 0.f, 0.f, 0.f};
    bf16x8 At[4][2], B0[2][2], B1[2][2];
    const char* cA = (const char*)g.A + (size_t)cur.pm * tstep; const char* cB = (const char*)g.Bt + (size_t)cur.pn * tstep;
    S.a_ready(cur);
    if constexpr (SP2) {
        PG8_STAGE(PG8_SB(0, 0), cB, voffB); PG8_STAGE(PG8_SB(0, 1), cB + hstep, voffB); PG8_STAGE(PG8_SA(0, 0), cA, voffA); PG8_STAGE(PG8_SA(0, 1), cA + hstep, voffA);
        if (wr == 1) PG8_BAR;
        PG8_WAIT_V(2); PG8_BAR;
        PG8_STAGE(PG8_SB(1, 0), cB + kstep, voffB); PG8_STAGE(PG8_SA(1, 0), cA + kstep, voffA); PG8_STAGE(PG8_SB(1, 1), cB + hstep + kstep, voffB);
        PG8_WAIT_V(6); PG8_BAR;
    } else {
        PG8_STAGE(PG8_SB(0, 0), cB, voffB); PG8_STAGE(PG8_SA(0, 0), cA, voffA); PG8_STAGE(PG8_SB(0, 1), cB + hstep, voffB); PG8_STAGE(PG8_SA(0, 1), cA + hstep, voffA);
        if (wr == 1) PG8_BAR;
        PG8_WAIT_V(4); PG8_BAR;
        PG8_STAGE(PG8_SB(1, 0), cB + kstep, voffB); PG8_STAGE(PG8_SA(1, 0), cA + kstep, voffA); PG8_STAGE(PG8_SB(1, 1), cB + hstep + kstep, voffB);
        PG8_WAIT_V(6); PG8_BAR;
    }
    for (;;) {
        const bool has_next = S.next(ui + 1, nxt);
        const char* nA = has_next ? (const char*)g.A + (size_t)nxt.pm * tstep : cA; const char* nB = has_next ? (const char*)g.Bt + (size_t)nxt.pn * tstep : cB;
        for (int t = 0; t < nt; t += 2) {
            const bool last = (t == nt - 2);
            const char* a1 = cA + (size_t)(t + 1) * kstep;
            const char* a2 = last ? nA : cA + (size_t)(t + 2) * kstep; const char* b2 = last ? nB : cB + (size_t)(t + 2) * kstep;
            const char* a3 = a2 + kstep; const char* b3 = b2 + kstep;
            if (last && has_next) S.a_ready(nxt);
            if constexpr (SP2) {
            PG8_LDB(B0, 0, 0); PG8_LDB(B1, 0, 1); PG8_SCHED; PG8_LDA(At, 0, 0); PG8_STAGE(PG8_SA(1, 1), a1 + hstep, voffA);
            PG8_WAIT_V(8); PG8_WAIT_L(0); PG8_BAR; PG8_MMA(0, 0, At, B0); PG8_MMA(0, 1, At, B1); PG8_BAR; PG8_SCHED;
            PG8_LDA(At, 0, 1); PG8_STAGE(PG8_SB(0, 0), b2, voffB); PG8_STAGE(PG8_SB(0, 1), b2 + hstep, voffB); PG8_STAGE(PG8_SA(0, 0), a2, voffA);
            PG8_WAIT_V(8); PG8_WAIT_L(0); PG8_BAR; PG8_MMA(1, 0, At, B0); PG8_MMA(1, 1, At, B1); PG8_BAR; PG8_SCHED;
            PG8_LDB(B0, 1, 0); PG8_LDB(B1, 1, 1); PG8_SCHED; PG8_LDA(At, 1, 0); PG8_STAGE(PG8_SA(0, 1), a2 + hstep, voffA);
            PG8_WAIT_V(8); PG8_WAIT_L(0); PG8_BAR; PG8_MMA(0, 0, At, B0); PG8_MMA(0, 1, At, B1); PG8_BAR; PG8_SCHED;
            PG8_LDA(At, 1, 1); PG8_STAGE(PG8_SB(1, 0), b3, voffB); PG8_STAGE(PG8_SB(1, 1), b3 + hstep, voffB); PG8_STAGE(PG8_SA(1, 0), a3, voffA);
            PG8_WAIT_V(8); PG8_WAIT_L(0); PG8_BAR; PG8_MMA(1, 0, At, B0); PG8_MMA(1, 1, At, B1); PG8_BAR; PG8_SCHED;
            } else {
            PG8_LDB(B0, 0, 0); PG8_SCHED; PG8_LDA(At, 0, 0); PG8_STAGE(PG8_SA(1, 1), a1 + hstep, voffA);
            PG8_WAIT_L(8); PG8_BAR; PG8_WAIT_L(0); PG8_MMA(0, 0, At, B0); PG8_BAR; PG8_SCHED;
            PG8_LDB(B1, 0, 1); PG8_STAGE(PG8_SB(0, 0), b2, voffB);
            PG8_BAR; PG8_WAIT_L(0); PG8_MMA(0, 1, At, B1); PG8_BAR;
            PG8_LDA(At, 0, 1); PG8_STAGE(PG8_SA(0, 0), a2, voffA);
            PG8_BAR; PG8_WAIT_L(0); PG8_MMA(1, 0, At, B0); PG8_BAR; PG8_SCHED;
            PG8_STAGE(PG8_SB(0, 1), b2 + hstep, voffB);
            PG8_WAIT_V(6); PG8_BAR; PG8_MMA(1, 1, At, B1); PG8_BAR;
            PG8_LDB(B0, 1, 0); PG8_SCHED; PG8_LDA(At, 1, 0); PG8_STAGE(PG8_SA(0, 1), a2 + hstep, voffA);
            PG8_WAIT_L(8); PG8_BAR; PG8_WAIT_L(0); PG8_MMA(0, 0, At, B0); PG8_BAR; PG8_SCHED;
            PG8_LDB(B1, 1, 1); PG8_STAGE(PG8_SB(1, 0), b3, voffB);
            PG8_BAR; PG8_WAIT_L(0); PG8_MMA(0, 1, At, B1); PG8_BAR;
            PG8_LDA(At, 1, 1); PG8_STAGE(PG8_SA(1, 0), a3, voffA);
            PG8_BAR; PG8_WAIT_L(0); PG8_MMA(1, 0, At, B0); PG8_BAR; PG8_SCHED;
            PG8_STAGE(PG8_SB(1, 1), b3 + hstep, voffB);
            PG8_WAIT_V(6); PG8_BAR; PG8_MMA(1, 1, At, B1); PG8_BAR;
            }
        }
        if constexpr (ALIGN_EPI) { if (wr == 0) PG8_BAR; }
        if constexpr (!Epi::AFTER_DRAIN) { E(acc, cur, wr, wc, fr, fq); S.done(cur); }
        if (!has_next) break;
#pragma unroll
        for (int a = 0; a < 2; ++a)
#pragma unroll
            for (int b = 0; b < 2; ++b)
#pragma unroll
                for (int m = 0; m < 4; ++m)
#pragma unroll
                    for (int n = 0; n < 2; ++n) acc[a][b][m][n] = (f32x4){0.f, 0.f, 0.f, 0.f};
        cur = nxt; cA = nA; cB = nB; ++ui;
        if constexpr (ALIGN_EPI) { if (wr == 1) PG8_BAR; }
    }
    PG8_WAIT_V(0);
    if constexpr (!ALIGN_EPI) { if (wr == 0) PG8_BAR; }
    PG8_BAR;
    if constexpr (Epi::AFTER_DRAIN) { E.fused(acc, cur, wr, wc, fr, fq, lds, wid, lane); S.done(cur); }
#undef PG8_SA
#undef PG8_SB
#undef PG8_STAGE
#undef PG8_LDA
#undef PG8_LDB
#undef PG8_MMA
#undef PG8_WAIT_V
#undef PG8_WAIT_L
#undef PG8_BAR
#undef PG8_SCHED
}
}
constexpr int NB = 2, SEQ = 8192, DM = 1024, TT = NB * SEQ, DFF = 2816, NLAYER = 2;
constexpr int NWAVES = 8, NTHR = 512;
typedef unsigned short bf16;
typedef float f32x4 __attribute__((ext_vector_type(4)));
typedef float f32x16 __attribute__((ext_vector_type(16)));
typedef short bf16x8 __attribute__((ext_vector_type(8)));
typedef unsigned u32x4 __attribute__((ext_vector_type(4)));
typedef unsigned u32x2 __attribute__((ext_vector_type(2)));
#define LAS __attribute__((address_space(3)))
#define GAS __attribute__((address_space(1)))
using pg8::cvt_pk_bf16; using pg8::bf_lo; using pg8::bf_hi;

constexpr size_t MiB = 1u << 20;
constexpr size_t WS_SSQ = 249 * MiB;
constexpr size_t WS_WGU1 = 1 * MiB, WS_WD1 = 12 * MiB, WS_WIN = 17 * MiB + 512 * 1024, WS_WG = 22 * MiB + 512 * 1024;
constexpr size_t WS_WUQ = 28 * MiB + 512 * 1024, WS_WUKV = WS_WUQ + 384 * 1024, WS_WPOOL = WS_WUKV + 256 * 1024, WS_WB = WS_WPOOL + 512 * 1024;
constexpr size_t WS_WOUT = WS_WB + 3 * MiB, WS_WGU2 = WS_WOUT + 2 * MiB, WS_WD2 = WS_WGU2 + 11 * MiB;
static_assert(WS_WD2 + (size_t)DM * DFF * 2 <= 52 * MiB, "weights");
constexpr size_t WS_HB = 52 * MiB;
constexpr size_t WS_HID = 84 * MiB;
constexpr size_t WS_Z1 = 84 * MiB, WS_Z2 = 116 * MiB, WS_VTD = 148 * MiB;
constexpr size_t WS_CQN = 164 * MiB, WS_CKVN = 172 * MiB, WS_KR = 176 * MiB, WS_POOLED = 177 * MiB;
constexpr size_t WS_QM = 193 * MiB, WS_KN = 217 * MiB, WS_VTM = 233 * MiB;
constexpr size_t WS_YPOOL = 84 * MiB, WS_OM = 100 * MiB, WS_OD = 177 * MiB;
constexpr size_t WS_GT = 193 * MiB, WS_MB = 116 * MiB;
constexpr size_t WS_ATTQ = 14336;
constexpr size_t WS_KMAX = 51 * MiB + 256 * 1024;
constexpr size_t WS_POSFLAG = 15360;
constexpr size_t WS_TAB = 768 * 1024;
constexpr size_t WS_END = 256 * MiB;

constexpr size_t WS_BAR = 0, BAR_ZERO_BYTES = 16384;
constexpr int LDS_BYTES = 147456, LDS_MISC = 131072 + 1024;

struct Args { const float* in[27]; float* out; unsigned char* ws; float invf[16]; float lam_init[2]; int ph_lo, ph_hi; };
static_assert(sizeof(Args) == 29 * 8 + 18 * 4 + 8, "Args has no padding");

__device__ __forceinline__ float wave_sum(float v) {
#pragma unroll
    for (int o = 1; o < 64; o <<= 1) v += __shfl_xor(v, o);
    return v;
}
__device__ __forceinline__ void sincos_acc(float ang, float& s, float& c) {
    double rev = (double)ang * 0.15915494309189535; rev -= __builtin_rint(rev); const float fr = (float)rev;
    s = __builtin_amdgcn_sinf(fr); c = __builtin_amdgcn_cosf(fr);
}

__device__ __forceinline__ void transpose_item(const float* W, int N, const float* gain, bf16* WT, int ldt, int k0, int n0, int drow, LAS float* scr, int lane) {
    const int kq = lane >> 3, n4 = (lane & 7) * 4;
#pragma unroll
    for (int i = 0; i < 8; ++i) { const int kk = kq + 8 * i; f32x4 v = *(const f32x4*)(W + (size_t)(k0 + kk) * N + n0 + n4); if (gain) v = v * gain[k0 + kk];
        LAS float* sp = scr + kk * 33 + n4; sp[0] = v.x; sp[1] = v.y; sp[2] = v.z; sp[3] = v.w; }
    asm volatile("s_waitcnt lgkmcnt(0)" ::: "memory");
    const int c = lane & 7;
#pragma unroll
    for (int j = 0; j < 4; ++j) { const int n = (lane >> 3) + 8 * j; const LAS float* s = scr + (8 * c) * 33 + n;
        u32x4 o; o.x = cvt_pk_bf16(s[0 * 33], s[1 * 33]); o.y = cvt_pk_bf16(s[2 * 33], s[3 * 33]); o.z = cvt_pk_bf16(s[4 * 33], s[5 * 33]); o.w = cvt_pk_bf16(s[6 * 33], s[7 * 33]);
        *(u32x4*)(WT + (size_t)(drow + n) * ldt + k0 + 8 * c) = o; }
    asm volatile("s_waitcnt lgkmcnt(0)" ::: "memory");
}
template <int MAP> __device__ __forceinline__ void conv_matrix(const float* W, int K, int N, const float* gain, bf16* WT, int& base, int gw, int NGW, LAS float* scr, int lane) {
    const int nblk = N / 32, nitems = (K / 64) * nblk;
    int first = (gw - base) % NGW; if (first < 0) first += NGW;
    for (int it = first; it < nitems; it += NGW) {
        const int kb = it / nblk, nb = it % nblk, n0 = 32 * nb; int drow = n0;
        if (MAP == 1) drow = (n0 >> 7) * 256 + (n0 & 127);
        if (MAP == 2) drow = (n0 >> 7) * 256 + 128 + (n0 & 127);
        if (MAP == 3) drow = n0 < 416 ? n0 : (n0 < 1952 ? n0 - 416 + 1024 : (n0 < 2464 ? n0 - 1952 + 512 : n0 + 96));
        transpose_item(W, N, gain, WT, K, 64 * kb, n0, drow, scr, lane);
    }
    base = (base + nitems) % NGW;
}

namespace att {
constexpr int VP = 136, VB = 64 * VP;
template <int MODE> struct Cfg { static constexpr int DQK = MODE == 0 ? 96 : 64, NQ = DQK / 16, KP = DQK * 2 + 16, KB = 64 * KP, BUF = KB + VB + 256; };
struct P { const bf16* Q; int qpitch; const bf16* K; int kpitch; const bf16* KR; const bf16* V; int vpitch; bf16* O; const int* pos; const float* invf;
           const float* subln; float lam_init; float lam; const float* kmax; int nblk; };
#define MFMA32(a, b, c) __builtin_amdgcn_mfma_f32_32x32x16_bf16((a), (b), (c), 0, 0, 0)
__device__ __forceinline__ int crow(int r, int hi) { return (r & 3) + 8 * (r >> 2) + 4 * hi; }
__device__ __forceinline__ bf16x8 pack_frag(const f32x16& p, int s) {
    u32x4 w; w.x = cvt_pk_bf16(p[8 * s + 0], p[8 * s + 1]); w.y = cvt_pk_bf16(p[8 * s + 2], p[8 * s + 3]); w.z = cvt_pk_bf16(p[8 * s + 4], p[8 * s + 5]); w.w = cvt_pk_bf16(p[8 * s + 6], p[8 * s + 7]);
    return __builtin_bit_cast(bf16x8, w);
}
__device__ __forceinline__ float max16(const f32x16& a) {
    float m0 = fmaxf(fmaxf(a[0], a[1]), fmaxf(a[2], a[3])), m1 = fmaxf(fmaxf(a[4], a[5]), fmaxf(a[6], a[7]));
    float m2 = fmaxf(fmaxf(a[8], a[9]), fmaxf(a[10], a[11])), m3 = fmaxf(fmaxf(a[12], a[13]), fmaxf(a[14], a[15]));
    return fmaxf(fmaxf(m0, m1), fmaxf(m2, m3));
}
__device__ __forceinline__ int imax16(const f32x16& a) {
#define FI(i) __float_as_int(a[i])
    const int m0 = max(max(FI(0), FI(1)), FI(2)), m1 = max(max(FI(3), FI(4)), FI(5)), m2 = max(max(FI(6), FI(7)), FI(8)), m3 = max(max(FI(9), FI(10)), FI(11)), m4 = max(max(FI(12), FI(13)), FI(14));
    return max(max(max(m0, m1), m2), max(max(m3, m4), FI(15)));
#undef FI
}
__device__ __forceinline__ float sum16(const f32x16& a) {
    return ((a[0] + a[1]) + (a[2] + a[3])) + ((a[4] + a[5]) + (a[6] + a[7])) + ((a[8] + a[9]) + (a[10] + a[11])) + ((a[12] + a[13]) + (a[14] + a[15]));
}
template <bool SUM> __device__ __forceinline__ bool softmax_tile(f32x16& pa, f32x16& pb, float& m, float& l, f32x16& o0, f32x16& o1, bool first) {
    float rm;
    if (first) { rm = fmaxf(max16(pa), max16(pb)); rm = fmaxf(rm, __shfl_xor(rm, 32)); }
    else { int im = max(imax16(pa), imax16(pb));
        const auto rr = __builtin_amdgcn_permlane32_swap((unsigned)im, (unsigned)im, false, false); im = max((int)rr[0], (int)rr[1]); rm = __int_as_float(im); }
    bool moved = false;
    if (first || __any(rm > 8.0f)) {
        asm volatile("" ::: "memory");
        const float dl = first ? rm : fmaxf(rm, 0.f); m += dl; moved = true;
        if (!first) { const float f = __builtin_amdgcn_exp2f(-dl); l *= f;
#pragma unroll
            for (int r = 0; r < 16; ++r) { o0[r] *= f; o1[r] *= f; } }
#pragma unroll
        for (int r = 0; r < 16; ++r) { pa[r] -= dl; pb[r] -= dl; }
    }
#pragma unroll
    for (int r = 0; r < 16; ++r) { pa[r] = __builtin_amdgcn_exp2f(pa[r]); pb[r] = __builtin_amdgcn_exp2f(pb[r]); }
    if (SUM) l += sum16(pa) + sum16(pb);
    return moved;
}

__device__ __forceinline__ void split3_bf16(float x, unsigned& h1, unsigned& h2, unsigned& h3) {
    h1 = cvt_pk_bf16(x, 0.f) & 0xffffu; const float r1 = x - bf_lo(h1); h2 = cvt_pk_bf16(r1, 0.f) & 0xffffu; const float r2 = r1 - bf_lo(h2); h3 = cvt_pk_bf16(r2, 0.f) & 0xffffu;
}
template <int MODE, bool FAST = false> __device__ __forceinline__ void attn_pass(LAS unsigned char* lds, const bf16x8 (&qr)[MODE == 0 ? 6 : 4], const bf16* kb_g, int kpitch, const bf16* kr_g,
                                                              const bf16* vb_g, int vpitch, const int* posb, float pqf, float slope2, float bq0, float bq1, int q0, int qrow, int w,
                                                              f32x16 (&o)[MODE == 0 ? 1 : 2][2], float (&l)[MODE == 0 ? 1 : 2]) {
    constexpr int NM = MODE == 0 ? 1 : 2, NQ = MODE == 0 ? 6 : 2, KP = (MODE == 0 ? 192 : 128) + 16, KB = 64 * KP, BUF = KB + VB + 256;
    int tid_l = threadIdx.x; asm volatile("" : "+v"(tid_l));
    const int tid = tid_l, lane = tid & 63, r32 = lane & 31, hi = lane >> 5;
    const int skey = tid >> 3, sch = tid & 7, skey2 = tid >> 2, sch2 = tid & 3;
    const GAS bf16* ksrc = (const GAS bf16*)(kb_g + (unsigned)(skey * kpitch + sch * 8));
    const GAS bf16* vsrc = (const GAS bf16*)(vb_g + (unsigned)(skey * SEQ + sch * 8));
    const GAS bf16* krsrc = (const GAS bf16*)(kr_g + (unsigned)(skey2 * 32 + sch2 * 8));
    const GAS int* posg = (const GAS int*)posb;
    u32x4 kreg, vreg, krreg = {0u, 0u, 0u, 0u}; float pkreg = 0.f;
    const int NT = (q0 + 256) / 64, ntw = (q0 + 32 * w) / 64 + 1;
    constexpr bool REV = (MODE == 1) && FAST;
    int wdone = 0;
#define ATT_LOAD(t) do { vreg = *(const GAS u32x4*)(vsrc + (unsigned)((t) * 64)); kreg = *(const GAS u32x4*)(ksrc + (unsigned)((t) * 64 * kpitch)); \
        if (MODE == 0) { if (tid < 256) krreg = *(const GAS u32x4*)(krsrc + (unsigned)((t) * 64 * 32)); } \
        else { if (tid < 64) pkreg = (float)posg[(t) * 64 + tid]; } } while (0)
#define ATT_STORE(bufi) do { LAS unsigned char* sb = lds + (bufi) * BUF; *(LAS u32x4*)(sb + skey * KP + sch * 16) = kreg; \
        if (MODE == 0) { if (tid < 256) *(LAS u32x4*)(sb + skey2 * KP + 128 + sch2 * 16) = krreg; } \
        else { if (tid < 64) *(LAS float*)(sb + KB + VB + tid * 4) = pkreg; } \
        LAS u32x2* vt = (LAS u32x2*)(sb + KB + skey * VP + sch * 16); vt[0] = (u32x2){vreg.x, vreg.y}; vt[1] = (u32x2){vreg.z, vreg.w}; } while (0)
    float m[NM];
    f32x16 negm, lsum;
#pragma unroll
    for (int r = 0; r < 16; ++r) { negm[r] = 0.f; lsum[r] = 0.f; }
#pragma unroll
    for (int i = 0; i < NM; ++i) { m[i] = 0.f; l[i] = (MODE == 0) ? 1.0f : 0.f;
#pragma unroll
        for (int r = 0; r < 16; ++r) { o[i][0][r] = 0.f; o[i][1][r] = 0.f; } }
    bf16x8 qx[2];
    if constexpr (MODE == 1 && FAST) { unsigned s1, s2, s3; split3_bf16(slope2, s1, s2, s3);
        const unsigned e1 = cvt_pk_bf16(bf_lo(s1) * 64.0f, bf_lo(s2) * 64.0f), e2 = (cvt_pk_bf16(bf_lo(s3) * 64.0f, 0.f) & 0xffffu) | (s1 << 16), e3 = s2 | (s3 << 16);
        const u32x4 qv = {hi ? 0u : e1, hi ? 0u : e2, hi ? 0u : e3, 0u}; qx[0] = __builtin_bit_cast(bf16x8, qv); qx[1] = qx[0]; }
    ATT_LOAD(REV ? NT - 1 : 0); ATT_STORE(0); __syncthreads();
    for (int it = 0; it < NT; ++it) {
        const int t = REV ? NT - 1 - it : it; const bool first_t = REV ? (t == ntw - 1) : (t == 0);
        if (it + 1 < NT) ATT_LOAD(REV ? t - 1 : t + 1);
        if (t < ntw && !wdone) {
            LAS unsigned char* bb = lds + (it & 1) * BUF;
            const LAS unsigned char* kb = bb + r32 * KP + 16 * hi;
            bf16x8 kf[NM][2][NQ];
            f32x16 dist[2];
            bf16x8 kx[2];
            if constexpr (MODE == 1 && !FAST) {
                const LAS float* pk = (const LAS float*)(bb + KB + VB);
#pragma unroll
                for (int hf = 0; hf < 2; ++hf)
#pragma unroll
                    for (int g = 0; g < 4; ++g) { const f32x4 pk4 = *(const LAS f32x4*)(pk + 32 * hf + 8 * g + 4 * hi);
#pragma unroll
                        for (int e = 0; e < 4; ++e) dist[hf][4 * g + e] = pqf - pk4[e]; }
            }
            if constexpr (MODE == 1 && FAST) {
                const LAS float* pk = (const LAS float*)(bb + KB + VB);
#pragma unroll
                for (int hf = 0; hf < 2; ++hf) { const float pv = pk[32 * hf + r32]; const float a = __builtin_floorf(pv * 0.015625f), bq = __builtin_fmaf(-64.0f, a, pv);
                    const unsigned aa = cvt_pk_bf16(a, a), ab = cvt_pk_bf16(a, bq), bb2 = cvt_pk_bf16(bq, bq);
                    const u32x4 kv = {hi ? 0x3f803f80u : aa, hi ? 0x00003f80u : ab, hi ? 0u : bb2, 0u}; kx[hf] = __builtin_bit_cast(bf16x8, kv); }
            }
            bf16x8 pf[NM][4];
#pragma unroll
            for (int mp = 0; mp < NM; ++mp) {
                f32x16 p[2];
#pragma unroll
                for (int hf = 0; hf < 2; ++hf)
#pragma unroll
                    for (int d = 0; d < NQ; ++d) kf[mp][hf][d] = *(const LAS bf16x8*)(kb + hf * 32 * KP + 32 * (mp * NQ + d));
                __builtin_amdgcn_sched_barrier(0);
                if constexpr (MODE == 1 && FAST) {
                    if (t == ntw - 1) {
                        int tt = t; asm volatile("" : "+s"(tt));
                        const float tb = (float)(qrow - 64 * tt - 4 * hi);
#pragma unroll
                        for (int hf = 0; hf < 2; ++hf) { f32x16 c;
#pragma unroll
                            for (int r = 0; r < 16; ++r) c[r] = fminf(tb - (float)(32 * hf + (r & 3) + 8 * (r >> 2)), 0.f) * 1e30f;
                            p[hf] = MFMA32(kx[hf], qx[mp], c); }
                    } else {
                        const f32x16 z16 = {0.f, 0.f, 0.f, 0.f, 0.f, 0.f, 0.f, 0.f, 0.f, 0.f, 0.f, 0.f, 0.f, 0.f, 0.f, 0.f};
#pragma unroll
                        for (int hf = 0; hf < 2; ++hf) p[hf] = MFMA32(kx[hf], qx[mp], z16);
                    }
#pragma unroll
                    for (int hf = 0; hf < 2; ++hf)
#pragma unroll
                        for (int d = 0; d < NQ; ++d) p[hf] = MFMA32(kf[mp][hf][d], qr[mp * NQ + d], p[hf]);
                } else if constexpr (MODE == 1) {
#pragma unroll
                    for (int hf = 0; hf < 2; ++hf)
#pragma unroll
                        for (int r = 0; r < 16; ++r) p[hf][r] = __builtin_fmaf(-slope2, __builtin_fabsf(dist[hf][r]), -m[mp]);
                    if (t == ntw - 1) {
                        int tt = t; asm volatile("" : "+s"(tt));
                        const float tb = (float)(qrow - 64 * tt - 4 * hi);
#pragma unroll
                        for (int hf = 0; hf < 2; ++hf)
#pragma unroll
                            for (int r = 0; r < 16; ++r) p[hf][r] += fminf(tb - (float)(32 * hf + (r & 3) + 8 * (r >> 2)), 0.f) * 1e30f;
                    }
#pragma unroll
                    for (int hf = 0; hf < 2; ++hf)
#pragma unroll
                        for (int d = 0; d < NQ; ++d) p[hf] = MFMA32(kf[mp][hf][d], qr[mp * NQ + d], p[hf]);
                } else {
                    if (t == ntw - 1) {
                        int tt = t; asm volatile("" : "+s"(tt));
                        const float tb = (float)(qrow - 64 * tt - 4 * hi);
#pragma unroll
                        for (int hf = 0; hf < 2; ++hf) { f32x16 c;
#pragma unroll
                            for (int r = 0; r < 16; ++r) c[r] = negm[r] + fminf(tb - (float)(32 * hf + (r & 3) + 8 * (r >> 2)), 0.f) * 1e30f;
                            p[hf] = MFMA32(kf[0][hf][0], qr[0], c); }
                    } else {
#pragma unroll
                        for (int hf = 0; hf < 2; ++hf) p[hf] = MFMA32(kf[0][hf][0], qr[0], negm);
                    }
#pragma unroll
                    for (int hf = 0; hf < 2; ++hf)
#pragma unroll
                        for (int d = 1; d < NQ; ++d) p[hf] = MFMA32(kf[0][hf][d], qr[d], p[hf]);
                }
                __builtin_amdgcn_sched_barrier(0);
                const float l_before = l[mp];
                const bool moved = softmax_tile<MODE == 1>(p[0], p[1], m[mp], l[mp], o[mp][0], o[mp][1], first_t);
                if constexpr (MODE == 1 && FAST) { if (moved) { unsigned h1, h2, h3; split3_bf16(-m[mp], h1, h2, h3);
                        if (hi) { const u32x4 qv = {h1 | (h2 << 16), h3, 0u, 0u}; qx[mp] = __builtin_bit_cast(bf16x8, qv); } } }
                if (MODE == 0 && moved) { const float f = first_t ? 0.f : l[0] / l_before;
#pragma unroll
                    for (int r = 0; r < 16; ++r) { negm[r] = -m[0]; lsum[r] *= f; } l[0] = 1.0f; }
#pragma unroll
                for (int ks = 0; ks < 4; ++ks) pf[mp][ks] = pack_frag(p[ks >> 1], ks & 1);
            }
            const LAS unsigned char* vb = bb + KB + r32 * VP + 8 * hi;
#pragma unroll
            for (int dh = 0; dh < 2; ++dh) {
                bf16x8 vf[4];
#pragma unroll
                for (int ks = 0; ks < 4; ++ks) {
                    const u32x2 v0 = *(const LAS u32x2*)(vb + dh * 32 * VP + 32 * ks), v1 = *(const LAS u32x2*)(vb + dh * 32 * VP + 32 * ks + 16);
                    const u32x4 vv = {v0.x, v0.y, v1.x, v1.y}; vf[ks] = __builtin_bit_cast(bf16x8, vv); }
                __builtin_amdgcn_sched_barrier(0);
#pragma unroll
                for (int ks = 0; ks < 4; ++ks)
#pragma unroll
                    for (int mp = 0; mp < NM; ++mp) o[mp][dh] = MFMA32(vf[ks], pf[mp][ks], o[mp][dh]);
                __builtin_amdgcn_sched_barrier(0);
            }
            if constexpr (MODE == 0) {
                const u32x4 o1 = {0x3f803f80u, 0x3f803f80u, 0x3f803f80u, 0x3f803f80u}; const bf16x8 ones = __builtin_bit_cast(bf16x8, o1);
#pragma unroll
                for (int ks = 0; ks < 4; ++ks) lsum = MFMA32(ones, pf[0][ks], lsum);
            }
        }
        if (it + 1 < NT) ATT_STORE((it + 1) & 1);
        if constexpr (REV) {
            if (!wdone && t <= ntw - 1 && t >= 1) { const float pkm = (float)posg[64 * (t - 1) + 63];
                const float v = fmaxf(bq0 - m[0], bq1 - m[NM - 1]) + slope2 * pkm; wdone = __all(v < -152.0f) ? 1 : 0; }
            if (__syncthreads_and(wdone)) break;
        } else __syncthreads();
    }
    if constexpr (MODE == 0) l[0] = 0.5f * lsum[0];
#undef ATT_LOAD
#undef ATT_STORE
}

template <int MODE, bool FAST = false> __device__ __forceinline__ void attn_unit(LAS unsigned char* lds, const P& A, int b, int h, int qb) {
    int tid_l = threadIdx.x; asm volatile("" : "+v"(tid_l));
    const int tid = tid_l, lane = tid & 63, r32 = lane & 31, hi = lane >> 5; const int w = __builtin_amdgcn_readfirstlane(tid >> 6);
    const int q0 = qb * 256, qrow = q0 + 32 * w + r32; const unsigned rowbase = (unsigned)b * SEQ;
    const float LOG2E = 1.4426950408889634f;
    f32x16 res[2];
    if constexpr (MODE == 0) {
        const float qscale = 0.10206207261596575f * LOG2E;
        bf16x8 qr[6];
        {
            const bf16* qs = A.Q + (size_t)(rowbase + qrow) * 768 + h * 96 + 8 * hi;
            u32x4 raw[6];
#pragma unroll
            for (int d0 = 0; d0 < 6; ++d0) raw[d0] = *(const u32x4*)(qs + 16 * d0);
            float x1[8], x2[8];
#pragma unroll
            for (int e = 0; e < 4; ++e) { x1[2 * e] = bf_lo(raw[4][e]); x1[2 * e + 1] = bf_hi(raw[4][e]); x2[2 * e] = bf_lo(raw[5][e]); x2[2 * e + 1] = bf_hi(raw[5][e]); }
            const float posf = (float)A.pos[rowbase + qrow];
#pragma unroll
            for (int e = 0; e < 8; ++e) { const float fq = A.invf[8 * hi + e]; float s, c; sincos_acc(posf * fq, s, c);
                const float a = x1[e], bb2 = x2[e]; x1[e] = (a * c - bb2 * s) * qscale; x2[e] = (bb2 * c + a * s) * qscale; }
#pragma unroll
            for (int d0 = 0; d0 < 4; ++d0) { u32x4 wv;
#pragma unroll
                for (int e = 0; e < 4; ++e) wv[e] = cvt_pk_bf16(bf_lo(raw[d0][e]) * qscale, bf_hi(raw[d0][e]) * qscale);
                qr[d0] = __builtin_bit_cast(bf16x8, wv); }
            u32x4 w4, w5;
#pragma unroll
            for (int e = 0; e < 4; ++e) { w4[e] = cvt_pk_bf16(x1[2 * e], x1[2 * e + 1]); w5[e] = cvt_pk_bf16(x2[2 * e], x2[2 * e + 1]); }
            qr[4] = __builtin_bit_cast(bf16x8, w4); qr[5] = __builtin_bit_cast(bf16x8, w5);
        }
        f32x16 o[1][2]; float l[1];
        attn_pass<0>(lds, qr, A.K + (size_t)rowbase * 512, 512, A.KR + (size_t)rowbase * 32, A.V + (size_t)(b * 8 + h) * 64 * SEQ, 0, nullptr, 0.f, 0.f, 0.f, 0.f, q0, qrow, w, o, l);
        const float inv = 1.0f / (l[0] + __shfl_xor(l[0], 32));
#pragma unroll
        for (int dh = 0; dh < 2; ++dh)
#pragma unroll
            for (int r = 0; r < 16; ++r) res[dh][r] = o[0][dh][r] * inv;
    } else {
        const float qscale = 0.17677669529663687f * LOG2E;
        const float pqf = (float)A.pos[rowbase + qrow], slope2 = __builtin_amdgcn_exp2f(-(float)(h + 1)) * LOG2E;
        const float lam = A.lam;
        bf16x8 qr[4];
        { const bf16* qs = A.Q + (size_t)(rowbase + qrow) * 1024 + h * 64 + 8 * hi;
#pragma unroll
          for (int d0 = 0; d0 < 4; ++d0) { const u32x4 raw = *(const u32x4*)(qs + 16 * d0); u32x4 wv;
#pragma unroll
              for (int e = 0; e < 4; ++e) wv[e] = cvt_pk_bf16(bf_lo(raw[e]) * qscale, bf_hi(raw[e]) * qscale);
              qr[d0] = __builtin_bit_cast(bf16x8, wv); } }
        float bq0 = 0.f, bq1 = 0.f;
        if constexpr (FAST) {
            float n0 = 0.f, n1 = 0.f;
#pragma unroll
            for (int d0 = 0; d0 < 4; ++d0) { const u32x4 qv = __builtin_bit_cast(u32x4, qr[d0]); float a = 0.f;
#pragma unroll
                for (int e = 0; e < 4; ++e) { const float x = bf_lo(qv[e]), y = bf_hi(qv[e]); a += x * x + y * y; }
                if (d0 < 2) n0 += a; else n1 += a; }
            n0 += __shfl_xor(n0, 32); n1 += __shfl_xor(n1, 32);
            float k0 = 0.f, k1 = 0.f; const float* km = A.kmax + (b * 16 + h * 2);
            for (int blk = lane; blk < A.nblk; blk += 64) { k0 = fmaxf(k0, km[blk * 32]); k1 = fmaxf(k1, km[blk * 32 + 1]); }
#pragma unroll
            for (int sft = 1; sft < 64; sft <<= 1) { k0 = fmaxf(k0, __shfl_xor(k0, sft)); k1 = fmaxf(k1, __shfl_xor(k1, sft)); }
            bq0 = 1.02f * sqrtf(n0 * k0) + 0.05f; bq1 = 1.02f * sqrtf(n1 * k1) + 0.05f;
        }
        f32x16 o[2][2]; float l[2];
        attn_pass<1, FAST>(lds, qr, A.K + (size_t)rowbase * 1024, 1024, nullptr, A.V + (size_t)(b * 8 + h) * 64 * SEQ, 0, A.pos + rowbase, pqf, slope2, bq0, bq1, q0, qrow, w, o, l);
        const float inv0 = 1.0f / (l[0] + __shfl_xor(l[0], 32)), inv1 = lam / (l[1] + __shfl_xor(l[1], 32));
        float ss = 0.f;
#pragma unroll
        for (int dh = 0; dh < 2; ++dh)
#pragma unroll
            for (int r = 0; r < 16; ++r) { const float v = o[0][dh][r] * inv0 - o[1][dh][r] * inv1; res[dh][r] = v; ss += v * v; }
        ss += __shfl_xor(ss, 32);
        const float rs = __builtin_amdgcn_rsqf(ss * (1.0f / 64.0f) + 1e-6f) * (1.0f - A.lam_init);
#pragma unroll
        for (int dh = 0; dh < 2; ++dh)
#pragma unroll
            for (int g = 0; g < 4; ++g) { const f32x4 sg = *(const f32x4*)(A.subln + 32 * dh + 8 * g + 4 * hi);
#pragma unroll
                for (int e = 0; e < 4; ++e) res[dh][4 * g + e] *= rs * sg[e]; }
    }
    bf16* orow = A.O + (size_t)(rowbase + qrow) * 512 + h * 64 + 4 * hi;
#pragma unroll
    for (int dh = 0; dh < 2; ++dh)
#pragma unroll
        for (int g = 0; g < 4; ++g) { u32x2 wv; wv.x = cvt_pk_bf16(res[dh][4 * g], res[dh][4 * g + 1]); wv.y = cvt_pk_bf16(res[dh][4 * g + 2], res[dh][4 * g + 3]);
            *(u32x2*)(orow + 32 * dh + 8 * g) = wv; }
}
}

#define XB_TMO      128
#define XB_XCNT(j)  (256  + 64 * (j))
#define XB_XSUB(j)  (1280 + 64 * (j))
#define XB_XGEN(j)  (2304 + 64 * (j))
#define XB_TOP      3328
#define XB_TOPGEN   3392
#define XCD_BAR_WORDS 3456
#define XB_SPIN_CAP (1u << 18)

__device__ __forceinline__ unsigned xb_ld(unsigned* p)              { return __hip_atomic_load(p, __ATOMIC_RELAXED, __HIP_MEMORY_SCOPE_AGENT); }
__device__ __forceinline__ unsigned xb_add(unsigned* p, unsigned v) { return __hip_atomic_fetch_add(p, v, __ATOMIC_RELAXED, __HIP_MEMORY_SCOPE_AGENT); }
__device__ __forceinline__ unsigned xb_xcc_id() { return (unsigned)__builtin_amdgcn_s_getreg((3 << 11) | 20) & 0xFu; }
#define XB_SPIN(cond, bar) do { unsigned _sp = 0; while (cond) { __builtin_amdgcn_s_sleep(1); \
    if ((++_sp & 255u) == 0u) { if (xb_ld(&(bar)[XB_TMO])) break; if (_sp > XB_SPIN_CAP) { atomicAdd(&(bar)[XB_TMO], 1u); break; } } } } while (0)

struct XcdBarrier {
    unsigned* bar; unsigned x;
    volatile LAS unsigned* st;
};

__device__ __forceinline__ XcdBarrier xcd_barrier_post(unsigned* bar, volatile LAS unsigned* st) {
    XcdBarrier b; b.bar = bar; b.x = xb_xcc_id(); b.st = st;
    if (threadIdx.x == 0) (void)xb_add(&bar[XB_XCNT(b.x)], 1u);
    return b;
}
__device__ __forceinline__ void xcd_barrier_complete(unsigned* bar, unsigned x, unsigned& nloc, unsigned& nx) {
    const unsigned G = gridDim.x * gridDim.y * gridDim.z;
    unsigned sum, cnt, mine, sp = 0u;
    for (;;) {
        sum = 0u; cnt = 0u; mine = 0u;
#pragma unroll
        for (unsigned j = 0; j < 16; ++j) { const unsigned c = xb_ld(&bar[XB_XCNT(j)]); sum += c; cnt += (c > 0u) ? 1u : 0u; mine = (j == x) ? c : mine; }
        if (sum == G) break;
        __builtin_amdgcn_s_sleep(1);
        if ((++sp & 255u) == 0u) { if (xb_ld(&bar[XB_TMO])) break; if (sp > XB_SPIN_CAP) { atomicAdd(&bar[XB_TMO], 1u); break; } }
    }
    nloc = mine > 0u ? mine : 1u; nx = cnt > 0u ? cnt : 1u;
}

__device__ __forceinline__ void xcd_barrier(const XcdBarrier& b) {
    asm volatile("s_waitcnt vmcnt(0)" ::: "memory");
    __syncthreads();
    if (threadIdx.x == 0) {
        unsigned* bar = b.bar;
        __builtin_amdgcn_s_waitcnt(0);
        unsigned nloc = b.st[0], nx = b.st[1];
        if (nloc == 0u) { xcd_barrier_complete(bar, b.x, nloc, nx); b.st[0] = nloc; b.st[1] = nx; }
        const unsigned old = xb_add(&bar[XB_XSUB(b.x)], 1u);
        const unsigned gen = old / nloc;
        if (old + 1u == (gen + 1u) * nloc) {
            __builtin_amdgcn_fence(__ATOMIC_RELEASE, "agent");
            asm volatile("s_waitcnt vmcnt(0)" ::: "memory");
            const unsigned og = xb_add(&bar[XB_TOP], 1u);
            const unsigned tg = og / nx;
            if (og + 1u == (tg + 1u) * nx) xb_add(&bar[XB_TOPGEN], 1u);
            else XB_SPIN(xb_ld(&bar[XB_TOPGEN]) == tg, bar);
            __builtin_amdgcn_fence(__ATOMIC_ACQUIRE, "agent");
            xb_add(&bar[XB_XGEN(b.x)], 1u);
            asm volatile("s_waitcnt vmcnt(0)" ::: "memory");
        } else {
            XB_SPIN(xb_ld(&bar[XB_XGEN(b.x)]) == gen, bar);
            __builtin_amdgcn_fence(__ATOMIC_ACQUIRE, "agent");
            asm volatile("s_waitcnt vmcnt(0)" ::: "memory");
        }
    }
    __syncthreads();
}
#ifndef ONLY
#define ONLY -1
#endif
#define EN(x) (ONLY < 0 || ONLY == (x))
__device__ __forceinline__ int opaque_i(int v) { asm volatile("" : "+s"(v)); return v; }
#define KL1 opaque_i(1024)
#define KL2 opaque_i(512)
#define KL3 opaque_i(256)
#define KL4 opaque_i(128)
#define KL5 opaque_i(DFF)
constexpr int PH_PER_LAYER = 11, N_PHASES = NLAYER * PH_PER_LAYER + 1;
__global__ void __launch_bounds__(NTHR) fwd_kernel(Args args) {
    extern __shared__ __attribute__((aligned(16))) unsigned char lds_raw[];
    LAS unsigned char* lds = (LAS unsigned char*)lds_raw;
    const int G0 = gridDim.x, bx0 = blockIdx.x;
    typedef const __attribute__((address_space(4))) Args KArgs;
    KArgs* const ap0 = (KArgs*)__builtin_amdgcn_kernarg_segment_ptr();
    unsigned char* const ws0 = args.ws;
    if (threadIdx.x < 2) ((volatile LAS unsigned*)(lds + LDS_MISC))[threadIdx.x] = 0u;
    __syncthreads();
    const bool use_bar = (args.ph_hi - args.ph_lo) > 1;
    XcdBarrier bar; bar.bar = (unsigned*)(ws0 + WS_BAR); bar.x = 0; bar.st = (volatile LAS unsigned*)(lds + LDS_MISC);
    if (use_bar) bar = xcd_barrier_post((unsigned*)(ws0 + WS_BAR), (volatile LAS unsigned*)(lds + LDS_MISC));
    const int lo = args.ph_lo, hi_ph = args.ph_hi;
    const bool multi = (hi_ph - lo) > 1;

    for (int ph = lo; ph < hi_ph; ++ph) {
        const int L = ph / PH_PER_LAYER, k = ph - L * PH_PER_LAYER;
        int tid = threadIdx.x; asm volatile("" : "+v"(tid)); const int lane = tid & 63, wave = __builtin_amdgcn_readfirstlane(tid >> 6);
        unsigned char* ws = ws0; asm volatile("" : "+s"(ws));
        int G = G0, bx = bx0; asm volatile("" : "+s"(G), "+s"(bx));
        const KArgs* ap = ap0; asm volatile("" : "+s"(ap));
        float* const ssq = (float*)(ws + WS_SSQ);   float* const hbuf = ap->out; bf16* const HB = (bf16*)(ws + WS_HB);
        const int vcu = (G % 8 == 0) ? (bx % 8) * (G / 8) + bx / 8 : bx;
        const int gw = vcu * NWAVES + wave, NGW = G * NWAVES;
        if (ph == N_PHASES - 1) {
            const float* gn = ap->in[26]; const float* sq = ssq + (size_t)(3 * NLAYER) * TT * 16;
            for (int row = gw; row < TT; row += NGW) {
                const float rs = __builtin_amdgcn_rsqf(pg8::row_ssq(sq, row) * (1.0f / DM) + 1e-6f);
                f32x4* xr = (f32x4*)(hbuf + (size_t)row * DM) + lane;
#pragma unroll
                for (int j = 0; j < 4; ++j) { const f32x4 v = xr[64 * j], gg = ((const f32x4*)gn)[lane + 64 * j]; xr[64 * j] = v * rs * gg; }
            }
        } else if (k == 0 && EN(0)) {
            LAS float* scr = (LAS float*)(lds + wave * 16384);
            int base = 0;
            for (int f = 0; f < 2; ++f) {
                const float* nrm = ap->in[f ? 22 : 2] + (size_t)L * DM; bf16* Wgu = (bf16*)(ws + (f ? WS_WGU2 : WS_WGU1));
                conv_matrix<1>(ap->in[f ? 23 : 3] + (size_t)L * DM * DFF, DM, DFF, nrm, Wgu, base, gw, NGW, scr, lane);
                conv_matrix<2>(ap->in[f ? 24 : 4] + (size_t)L * DM * DFF, DM, DFF, nrm, Wgu, base, gw, NGW, scr, lane);
                conv_matrix<0>(ap->in[f ? 25 : 5] + (size_t)L * DFF * DM, DFF, DM, nullptr, (bf16*)(ws + (f ? WS_WD2 : WS_WD1)), base, gw, NGW, scr, lane);
            }
            conv_matrix<3>(ap->in[7] + (size_t)L * DM * 5536, DM, 5536, ap->in[6] + (size_t)L * DM, (bf16*)(ws + WS_WIN), base, gw, NGW, scr, lane);
            conv_matrix<0>(ap->in[9] + (size_t)L * 256 * 768, 256, 768, nullptr, (bf16*)(ws + WS_WUQ), base, gw, NGW, scr, lane);
            conv_matrix<0>(ap->in[11] + (size_t)L * 128 * 1024, 128, 1024, nullptr, (bf16*)(ws + WS_WUKV), base, gw, NGW, scr, lane);
            for (int i = 0; i < 3; ++i) conv_matrix<0>(ap->in[20] + ((size_t)L * 3 + i) * 512 * 1024, 512, 1024, nullptr, (bf16*)(ws + WS_WB) + (size_t)i * 1024 * 512, base, gw, NGW, scr, lane);
            conv_matrix<0>(ap->in[21] + (size_t)L * DM * DM, DM, DM, nullptr, (bf16*)(ws + WS_WOUT), base, gw, NGW, scr, lane);
            const int gt = bx * NTHR + tid, ngt = G * NTHR;
            if (L == 0 && gt == 0) {
#pragma unroll
                for (int i = 0; i < 16; ++i) ((float*)(ws + WS_TAB))[i] = ap->invf[i]; }
            if (L == 0) {
                const int* posv = (const int*)ap->in[1]; bool bad = false;
                for (int i = gt; i < TT; i += ngt) { const int pv = posv[i]; bad |= (pv < 0) | (pv >= 16384); if ((i & (SEQ - 1)) != 0) bad |= (posv[i - 1] > pv); }
                if (bad) *(volatile unsigned*)(ws + WS_POSFLAG) = 1u; }
            { const float* pool_w = ap->in[17] + (size_t)L * 4 * 128 * 128; bf16* Wpool = (bf16*)(ws + WS_WPOOL);
              for (int i = gt; i < 512 * 512; i += ngt) { const int n = i >> 9, kk = i & 511; float v = 0.f; if ((n >> 7) == (kk >> 7)) v = pool_w[(size_t)(n >> 7) * 16384 + (kk & 127) * 128 + (n & 127)]; Wpool[i] = (bf16)(cvt_pk_bf16(v, 0.f) & 0xffffu); } }
            for (int i = gt; i < 96 * 1024 / 8; i += ngt) ((u32x4*)((bf16*)(ws + WS_WIN) + (size_t)416 * 1024))[i] = (u32x4){0u, 0u, 0u, 0u};
            if (L == 0) {
                const float* x = ap->in[0];
                for (int row = gw; row < TT; row += NGW) {
                    const f32x4* xr = (const f32x4*)(x + (size_t)row * DM) + lane; float s = 0.f;
#pragma unroll
                    for (int j = 0; j < 4; ++j) { const f32x4 v = xr[64 * j]; s += (v.x * v.x + v.y * v.y) + (v.z * v.z + v.w * v.w);
                        u32x2 o; o.x = cvt_pk_bf16(v.x, v.y); o.y = cvt_pk_bf16(v.z, v.w); ((u32x2*)(HB + (size_t)row * DM))[lane + 64 * j] = o; }
                    s = wave_sum(s); if (lane < 16) ssq[(size_t)row * 16 + lane] = lane == 0 ? s : 0.f;
                }
            }
        } else if ((k == 1 || k == 9) && EN(1)) {
            pg8::Gemm g{HB, (const bf16*)(ws + (k == 1 ? WS_WGU1 : WS_WGU2)), TT, 2 * DFF, KL1}; pg8::StaticOrder S; S.init(TT, 2 * DFF, G, bx);
            pg8::Epi<1> E{}; E.O = (bf16*)(ws + WS_HID); E.ldc = DFF; E.ssq = ssq + (size_t)(3 * L + (k == 1 ? 0 : 2)) * TT * 16; E.inv_n = 1.0f / DM;
            pg8::gemm_phase<pg8::Epi<1>, pg8::StaticOrder, true, true>(lds, g, S, E);
        } else if ((k == 2 || k == 8 || k == 10) && EN(2)) {
            pg8::Gemm g{(const bf16*)(ws + (k == 8 ? WS_MB : WS_HID)), (const bf16*)(ws + (k == 2 ? WS_WD1 : (k == 8 ? WS_WOUT : WS_WD2))), TT, DM, k == 8 ? KL1 : KL5};
            pg8::StaticOrder S; S.init(TT, DM, G, bx);
            pg8::Epi<2> E{}; E.O = (ph == N_PHASES - 2) ? nullptr : HB; E.ldc = DM; E.base = (ph == 2) ? ap->in[0] : hbuf; E.outf = hbuf; E.alpha = __uint_as_float((unsigned)__builtin_amdgcn_readfirstlane(k == 8 ? 0x3f800000 : 0x3f000000));
            E.ssq_out = ssq + (size_t)(3 * L + (k == 2 ? 1 : (k == 8 ? 2 : 3))) * TT * 16;
            pg8::gemm_phase<pg8::Epi<2>, pg8::StaticOrder, true, true>(lds, g, S, E);
        } else if (k == 3 && EN(3)) {
            pg8::Gemm g{HB, (const bf16*)(ws + WS_WIN), TT, 2560, KL1}; pg8::StaticOrder S; S.init(TT, 2560, G, bx);
            pg8::Epi<0> E{}; E.O = (bf16*)(ws + WS_Z1); E.ldc = 1024; E.O2 = (bf16*)(ws + WS_Z2); E.ldc2 = 1024; E.split = 1024; E.G = (const bf16*)(ws + WS_VTD); E.ssq = ssq + (size_t)(3 * L + 1) * TT * 16; E.inv_n = 1.0f / DM;
            pg8::gemm_phase<pg8::Epi<0>, pg8::StaticOrder, true, true>(lds, g, S, E);
        } else if (k == 5 && EN(5)) {
            { pg8::Gemm g{(const bf16*)(ws + WS_CQN), (const bf16*)(ws + WS_WUQ), TT, 768, KL3}; pg8::StaticOrder S; S.init(TT, 768, G, bx);
              pg8::Epi<6> E{}; E.O = (bf16*)(ws + WS_QM); E.ldc = 768; pg8::gemm_phase<pg8::Epi<6>, pg8::StaticOrder, true, true>(lds, g, S, E); }
            __syncthreads();
            { pg8::Gemm g{(const bf16*)(ws + WS_CKVN), (const bf16*)(ws + WS_WUKV), TT, 1024, KL4}; pg8::StaticOrder S; S.init(TT, 1024, G, bx);
              pg8::Epi<7> E{}; E.O = (bf16*)(ws + WS_KN); E.ldc = 512; E.O2 = (bf16*)(ws + WS_VTM); pg8::gemm_phase<pg8::Epi<7>, pg8::StaticOrder, true, true>(lds, g, S, E); }
            __syncthreads();
            { pg8::Gemm g{(const bf16*)(ws + WS_POOLED), (const bf16*)(ws + WS_WPOOL), TT, 512, KL2}; pg8::StaticOrder S; S.init(TT, 512, G, bx);
              pg8::Epi<3> E{}; E.O = (bf16*)(ws + WS_YPOOL); E.ldc = 512; E.bias = ap->in[18] + L * 512; E.scale = ap->in[19] + L * 512;
              pg8::gemm_phase<pg8::Epi<3>, pg8::StaticOrder, true, true>(lds, g, S, E); }
        } else if (k == 4 && EN(4)) {
            const bf16* Z1 = (const bf16*)(ws + WS_Z1); bf16* CQN = (bf16*)(ws + WS_CQN); bf16* CKVN = (bf16*)(ws + WS_CKVN); bf16* KR = (bf16*)(ws + WS_KR); bf16* PO = (bf16*)(ws + WS_POOLED);
            const float* q_norm = ap->in[8] + (size_t)L * 256; const float* kv_norm = ap->in[10] + (size_t)L * 128; const int* pos = (const int*)ap->in[1];
            float kmx0 = 0.f, kmx1 = 0.f;
            for (int t = gw; t < TT; t += NGW) {
                const bf16* zr = Z1 + (size_t)t * 1024;
                { const u32x4 kv = *(const u32x4*)((const bf16*)(ws + WS_Z2) + (size_t)t * 1024 + 512 + 8 * lane); float ss = 0.f;
#pragma unroll
                  for (int e = 0; e < 4; ++e) { const float x = bf_lo(kv[e]), y = bf_hi(kv[e]); ss += x * x + y * y; }
                  ss += __shfl_xor(ss, 1); ss += __shfl_xor(ss, 2);
                  if (t < SEQ) kmx0 = fmaxf(kmx0, ss); else kmx1 = fmaxf(kmx1, ss); }
                { const u32x2 v = ((const u32x2*)zr)[lane]; float x0 = bf_lo(v.x), x1 = bf_hi(v.x), x2 = bf_lo(v.y), x3 = bf_hi(v.y);
                  const float rs = __builtin_amdgcn_rsqf(wave_sum(x0 * x0 + x1 * x1 + x2 * x2 + x3 * x3) * (1.0f / 256.0f) + 1e-6f); const f32x4 gq = ((const f32x4*)q_norm)[lane];
                  u32x2 o; o.x = cvt_pk_bf16(x0 * rs * gq.x, x1 * rs * gq.y); o.y = cvt_pk_bf16(x2 * rs * gq.z, x3 * rs * gq.w); ((u32x2*)(CQN + (size_t)t * 256))[lane] = o; }
                { const unsigned v = ((const unsigned*)(zr + 256))[lane]; float x0 = bf_lo(v), x1 = bf_hi(v);
                  const float rs = __builtin_amdgcn_rsqf(wave_sum(x0 * x0 + x1 * x1) * (1.0f / 128.0f) + 1e-6f);
                  ((unsigned*)(CKVN + (size_t)t * 128))[lane] = cvt_pk_bf16(x0 * rs * kv_norm[2 * lane], x1 * rs * kv_norm[2 * lane + 1]); }
                if (lane < 16) { const float x1 = bf_lo((unsigned)zr[384 + lane]), x2 = bf_lo((unsigned)zr[400 + lane]); float s, c; sincos_acc((float)pos[t] * ((const float*)(ws + WS_TAB))[lane], s, c);
                  KR[(size_t)t * 32 + lane] = (bf16)(cvt_pk_bf16(x1 * c - x2 * s, 0.f) & 0xffffu); KR[(size_t)t * 32 + 16 + lane] = (bf16)(cvt_pk_bf16(x2 * c + x1 * s, 0.f) & 0xffffu); }
                { const int tp = t & (SEQ - 1), wdw = 2 << (lane >> 4), cnt = (tp + 1) < wdw ? (tp + 1) : wdw;
                  float a[8]; const u32x4 cur = *(const u32x4*)(zr + 512 + 8 * lane);
#pragma unroll
                  for (int e = 0; e < 4; ++e) { a[2 * e] = bf_lo(cur[e]); a[2 * e + 1] = bf_hi(cur[e]); }
                  float sm[8];
#pragma unroll
                  for (int e = 0; e < 8; ++e) sm[e] = a[e];
                  for (int j = 1; j < cnt; ++j) { const u32x4 pv = *(const u32x4*)(zr - (size_t)j * 1024 + 512 + 8 * lane);
#pragma unroll
                      for (int e = 0; e < 4; ++e) { sm[2 * e] += bf_lo(pv[e]); sm[2 * e + 1] += bf_hi(pv[e]); } }
                  const float ic = 1.0f / (float)cnt; u32x4 o;
#pragma unroll
                  for (int e = 0; e < 4; ++e) o[e] = cvt_pk_bf16(sm[2 * e] * ic - a[2 * e], sm[2 * e + 1] * ic - a[2 * e + 1]);
                  *(u32x4*)(PO + (size_t)t * 512 + 8 * lane) = o; }
            }
            {
                LAS float* red = (LAS float*)lds;
                if ((lane & 3) == 0) { red[(wave * 2 + 0) * 16 + (lane >> 2)] = kmx0; red[(wave * 2 + 1) * 16 + (lane >> 2)] = kmx1; }
                __syncthreads();
                if (tid < 32 && bx < 1024) { float mx = 0.f;
#pragma unroll
                    for (int wv = 0; wv < 8; ++wv) mx = fmaxf(mx, red[(wv * 2 + (tid >> 4)) * 16 + (tid & 15)]);
                    ((float*)(ws + WS_KMAX))[((size_t)L * 1024 + bx) * 32 + tid] = mx; }
                __syncthreads();
            }
        } else if (k == 6 && EN(6)) {
            const int* pos = (const int*)ap->in[1];
            float lam_u;
            { float a1 = lane < 32 ? ap->in[12][L * 32 + lane] * ap->in[13][L * 32 + lane] : 0.f, a2 = lane < 32 ? ap->in[14][L * 32 + lane] * ap->in[15][L * 32 + lane] : 0.f;
              a1 = wave_sum(a1); a2 = wave_sum(a2); const float lv = __expf(a1) - __expf(a2) + (L == 0 ? ap->lam_init[0] : ap->lam_init[1]);
              lam_u = __uint_as_float((unsigned)__builtin_amdgcn_readfirstlane((int)__float_as_uint(lv))); }
            const bool pos_generic = __builtin_amdgcn_readfirstlane((int)__hip_atomic_load((const unsigned*)(ws + WS_POSFLAG), __ATOMIC_RELAXED, __HIP_MEMORY_SCOPE_AGENT)) != 0 || G > 1024;
            {
                volatile LAS unsigned* qslot = (volatile LAS unsigned*)(lds + LDS_MISC + 64);
                const unsigned myx = bar.x & 7u;
                int stage = 0;
                while (stage < 10) {
                    const int qword = (stage == 0) ? 0 : (stage == 9 ? 9 : 1 + (int)((myx + (unsigned)(stage - 1)) & 7u));
                    unsigned* head = (unsigned*)(ws + WS_ATTQ + 512 * L + 48 * qword);
                    if (tid == 0) *qslot = __hip_atomic_fetch_add(head, 1u, __ATOMIC_RELAXED, __HIP_MEMORY_SCOPE_AGENT);
                    __syncthreads();
                    const int idx = __builtin_amdgcn_readfirstlane((int)*qslot);
                    __syncthreads();
                    const int qlen = (stage == 0 || stage == 9) ? 256 : 64;
                    if (idx >= qlen) { ++stage; continue; }
                    int type, qb, b, h;
                    if (stage == 0) { const int r = idx & 7; type = 1; qb = 31 - (idx >> 3); h = 4 + (r & 3); b = r >> 2; }
                    else if (stage == 9) { const int r = idx & 63; type = 1; h = 3 - (idx >> 6); b = r & 1; qb = 31 - (r >> 1); }
                    else { const int bh = 2 * (qword - 1) + (idx & 1); type = 0; qb = 31 - (idx >> 1); b = bh >> 3; h = bh & 7; }
                    if (type == 0) {
#ifndef NO_ATT0
                        att::P A{}; A.Q = (const bf16*)(ws + WS_QM); A.qpitch = 768; A.K = (const bf16*)(ws + WS_KN) + h * 64; A.kpitch = 512; A.KR = (const bf16*)(ws + WS_KR);
                        A.V = (const bf16*)(ws + WS_VTM); A.vpitch = 0; A.O = (bf16*)(ws + WS_OM); A.pos = pos; A.invf = (const float*)(ws + WS_TAB);
                        att::attn_unit<0>(lds, A, b, h, qb);
#endif
                    } else {
#ifndef NO_ATT1
                        att::P A{}; A.Q = (const bf16*)(ws + WS_Z2); A.qpitch = 1024; A.K = (const bf16*)(ws + WS_Z2) + 512 + h * 64; A.kpitch = 1024; A.V = (const bf16*)(ws + WS_VTD); A.vpitch = 0;
                        A.O = (bf16*)(ws + WS_OD); A.pos = pos; A.subln = ap->in[16] + L * 64; A.lam = lam_u; A.kmax = (const float*)(ws + WS_KMAX) + (size_t)L * 1024 * 32; A.nblk = G;
                        A.lam_init = L == 0 ? ap->lam_init[0] : ap->lam_init[1];
                        if (pos_generic) att::attn_unit<1, false>(lds, A, b, h, qb); else att::attn_unit<1, true>(lds, A, b, h, qb);
#endif
                    }
                }
            }
        } else if (k == 7 && EN(7)) {
#pragma nounroll
            for (int i = 0; i < 3; ++i) {
                { pg8::Gemm g{HB, (const bf16*)(ws + WS_WG) + (size_t)i * 1024 * 1024, TT, 1024, KL1}; pg8::StaticOrder S; S.init(TT, 1024, G, bx);
                  pg8::Epi<4> E{}; E.O = (bf16*)(ws + WS_GT); E.ldc = 1024; E.ssq = ssq + (size_t)(3 * L + 1) * TT * 16; E.inv_n = 1.0f / DM; pg8::gemm_phase<pg8::Epi<4>, pg8::StaticOrder, true, true>(lds, g, S, E); }
                __syncthreads();
                { const bf16* Oi = (const bf16*)(ws + (i == 0 ? WS_OM : (i == 1 ? WS_OD : WS_YPOOL)));
                  pg8::Gemm g{Oi, (const bf16*)(ws + WS_WB) + (size_t)i * 1024 * 512, TT, 1024, KL2}; pg8::StaticOrder S; S.init(TT, 1024, G, bx);
                  pg8::Epi<5> E{}; E.O = (bf16*)(ws + WS_MB); E.ldc = 1024; E.G = (const bf16*)(ws + WS_GT); E.first = (i == 0); pg8::gemm_phase<pg8::Epi<5>, pg8::StaticOrder, true, true>(lds, g, S, E); }
                __syncthreads();
            }
        }
        if (multi && ph + 1 < hi_ph) { if (lo == 0x7fffff01) cg::this_grid().sync();   else xcd_barrier(bar); }
    }
}

#ifndef MK_PER_PHASE
#define MK_PER_PHASE 0
#endif
extern "C" void kernel_launch(void* const* d_in, const int* in_sizes, int n_in, void* d_out, int out_size, void* d_ws, size_t ws_size, hipStream_t stream) {
    static int grid = 0;
    if (grid == 0) {
        if (n_in != 27 || out_size != TT * DM || ws_size < WS_END) { fprintf(stderr, "kernel_launch: unexpected shapes (n_in %d out %d ws %zu)\n", n_in, out_size, ws_size); grid = -1; return; }
        int dev = 0, cus = 0, per_cu = 0;
        (void)hipGetDevice(&dev); (void)hipDeviceGetAttribute(&cus, hipDeviceAttributeMultiprocessorCount, dev);
        if (hipFuncSetAttribute((const void*)fwd_kernel, hipFuncAttributeMaxDynamicSharedMemorySize, LDS_BYTES) != hipSuccess) { fprintf(stderr, "kernel_launch: hipFuncSetAttribute failed\n"); grid = -1; return; }
        if (hipOccupancyMaxActiveBlocksPerMultiprocessor(&per_cu, (const void*)fwd_kernel, NTHR, LDS_BYTES) != hipSuccess || per_cu < 1) { fprintf(stderr, "kernel_launch: occupancy query says %d\n", per_cu); per_cu = 1; }
        (void)hipGetLastError();
        grid = cus * 1;
        fprintf(stderr, "kernel_launch: grid %d (cus %d, per_cu %d)\n", grid, cus, per_cu);
    }
    if (grid < 0) return;
    (void)hipMemsetAsync((char*)d_ws + WS_BAR, 0, BAR_ZERO_BYTES, stream);
    Args a{};
    for (int i = 0; i < 27; ++i) a.in[i] = (const float*)d_in[i];
    a.out = (float*)d_out; a.ws = (unsigned char*)d_ws;
    for (int i = 0; i < 16; ++i) a.invf[i] = (float)pow(10000.0, -(double)i / 16.0);
    for (int l = 0; l < 2; ++l) a.lam_init[l] = (float)(0.8 - 0.6 * exp(-0.3 * l));
#if MK_PER_PHASE
    for (int p = 0; p < N_PHASES; ++p) { a.ph_lo = p; a.ph_hi = p + 1; hipLaunchKernelGGL(fwd_kernel, dim3(grid), dim3(NTHR), LDS_BYTES, stream, a); }
#else
    a.ph_lo = 0; a.ph_hi = N_PHASES;
    void* kargs[] = {&a};
    hipError_t e = hipLaunchCooperativeKernel((const void*)fwd_kernel, dim3(grid), dim3(NTHR), kargs, LDS_BYTES, stream);
    if (e != hipSuccess) fprintf(stderr, "cooperative launch failed: %s (grid %d)\n", hipGetErrorString(e), grid);
#endif
}
```

```cpp
#include <hip/hip_runtime.h>
#include <hip/hip_cooperative_groups.h>
#include <cstdio>
#include <cstdint>
#include <cmath>
namespace cg = cooperative_groups;
namespace pg8 {
#define PG8_LAS __attribute__((address_space(3)))
typedef unsigned short bf16_t;
typedef short bf16x8 __attribute__((ext_vector_type(8)));
typedef float f32x4 __attribute__((ext_vector_type(4)));
typedef unsigned u32x4 __attribute__((ext_vector_type(4)));
constexpr int BM = 256, BK = 64, HALF = 128, HTB = HALF * BK * 2  , STAGE_BYTES = 8 * HTB, NXCD = 8, WGM = 8;

__host__ __device__ __forceinline__ int lds_byte(int r, int c) { const int st = (r >> 4) * 2 + (c >> 5), rr = r & 15, cc = c & 31, ob = rr * 64 + cc * 2; return st * 1024 + (ob ^ (((ob >> 9) & 1) << 5)); }
__host__ __device__ __forceinline__ void stage_rc(int b, int& R, int& C) { const int st = b / 1024, sb = b % 1024, swz = sb ^ (((sb >> 9) & 1) << 5); R = (st >> 1) * 16 + swz / 64; C = (st & 1) * 32 + (swz % 64) / 2; }
__host__ __device__ __forceinline__ int perm32(int rho) { const int n = rho >> 4, i = rho & 15; return 8 * (i >> 2) + 4 * n + (i & 3); }

struct Unit { int pm, pn; };
struct Gemm { const bf16_t* A; const bf16_t* Bt; int M, N, K; };

struct StaticOrder {
    int nM, nN, nwg, G, c;
    __host__ __device__ void init(int M, int N, int G_, int c_) { nM = M / BM; nN = N / BM; nwg = nM * nN; G = G_; c = c_; }
    __host__ __device__ bool next(int i, Unit& u) const {
        const long L = (long)i * G + c; if (L >= nwg) return false;
        int wgid = (int)L; { const int q = nwg / NXCD, r = nwg % NXCD, xcd = wgid % NXCD, off = wgid / NXCD; wgid = (xcd < r ? xcd * (q + 1) : r * (q + 1) + (xcd - r) * q) + off; }
        const int nig = WGM * nN, gid = wgid / nig, fm = gid * WGM, gsz = (nM - fm) < WGM ? (nM - fm) : WGM;
        u.pm = fm + ((wgid % nig) % gsz); u.pn = (wgid % nig) / gsz; return true;
    }
    __device__ __forceinline__ void a_ready(const Unit&) const {}
    __device__ __forceinline__ void done(const Unit&) const {}
};

typedef float f32x2_cv __attribute__((ext_vector_type(2))); typedef __bf16 bf16x2_cv __attribute__((ext_vector_type(2)));
__device__ __forceinline__ unsigned cvt_pk_bf16(float lo, float hi) { f32x2_cv v = {lo, hi}; bf16x2_cv b = __builtin_convertvector(v, bf16x2_cv); return __builtin_bit_cast(unsigned, b); }
typedef float f32x2 __attribute__((ext_vector_type(2)));
typedef unsigned u32x2 __attribute__((ext_vector_type(2)));
constexpr float RMS_EPS = 1e-6f;
__device__ __forceinline__ float sigmoid_f(float x) { return __builtin_amdgcn_rcpf(1.f + __builtin_amdgcn_exp2f(-1.4426950408889634f * x)); }
__device__ __forceinline__ float row_ssq(const float* ssq, int r) { const f32x4* p = (const f32x4*)(ssq + (unsigned)(r * 16)); const f32x4 a = p[0], b = p[1], c = p[2], d = p[3];
    return ((a[0] + a[1]) + (a[2] + a[3])) + ((b[0] + b[1]) + (b[2] + b[3])) + ((c[0] + c[1]) + (c[2] + c[3])) + ((d[0] + d[1]) + (d[2] + d[3])); }
__device__ __forceinline__ float bf_lo(unsigned u) { return __uint_as_float(u << 16); }
__device__ __forceinline__ float bf_hi(unsigned u) { return __uint_as_float(u & 0xffff0000u); }
__device__ __forceinline__ u32x4 pack8(const f32x4 v0, const f32x4 v1) { u32x4 w; w.x = cvt_pk_bf16(v0[0], v0[1]); w.y = cvt_pk_bf16(v0[2], v0[3]); w.z = cvt_pk_bf16(v1[0], v1[1]); w.w = cvt_pk_bf16(v1[2], v1[3]); return w; }
template <int MODE> struct Epi {
    static constexpr bool PERM = true, AFTER_DRAIN = false;
    bf16_t* O; int ldc; bf16_t* O2; int ldc2; int split;
    const float* ssq; float inv_n;
    const float* base; float* outf; float alpha; float* ssq_out;
    const float* bias; const float* scale;
    const bf16_t* G; int first;
    __device__ __forceinline__ void operator()(const f32x4 (&acc)[2][2][4][2], const Unit& u, int wr, int wc, int fr, int fq) const {
        bf16_t* O = this->O; bf16_t* O2 = this->O2; const float* ssq = this->ssq; const float* base = this->base; float* outf = this->outf; float* ssq_out = this->ssq_out;
        const float* bias = this->bias; const float* scale = this->scale; const bf16_t* G = this->G; unsigned alpha_u = __float_as_uint(this->alpha), inv_u = __float_as_uint(this->inv_n);
        asm volatile("" : "+s"(O), "+s"(O2), "+s"(ssq), "+s"(base), "+s"(outf), "+s"(ssq_out));
        asm volatile("" : "+s"(bias), "+s"(scale), "+s"(G), "+s"(alpha_u), "+s"(inv_u));
        const float alpha = __uint_as_float(alpha_u), inv_n = __uint_as_float(inv_u);
        { int t_ = threadIdx.x; asm volatile("" : "+v"(t_)); fr = t_ & 15; fq = (t_ >> 4) & 3; }
        const int row0 = u.pm * BM + wr * 64 + fr;
        if constexpr (MODE == 1) {
            const int col0 = u.pn * HALF + wc * 32 + 8 * fq;
#pragma unroll
            for (int ai = 0; ai < 2; ++ai)
#pragma unroll
                for (int m = 0; m < 4; ++m) { const int r = row0 + ai * HALF + m * 16; const float sc = __builtin_amdgcn_rsqf(row_ssq(ssq, r) * inv_n + RMS_EPS);
                    f32x4 o[2];
#pragma unroll
                    for (int n = 0; n < 2; ++n)
#pragma unroll
                        for (int e = 0; e < 4; ++e) { const float g = acc[ai][0][m][n][e] * sc, uu = acc[ai][1][m][n][e] * sc; o[n][e] = g * sigmoid_f(g) * uu; }
                    *(u32x4*)(O + (unsigned)(r * ldc + col0)) = pack8(o[0], o[1]); }
        } else if constexpr (MODE == 2) {
#pragma unroll
            for (int ai = 0; ai < 2; ++ai)
#pragma unroll
                for (int m = 0; m < 4; ++m) { const int r = row0 + ai * HALF + m * 16; float s = 0.f;
#pragma unroll
                    for (int bj = 0; bj < 2; ++bj) { const unsigned off = (unsigned)(r * 1024 + u.pn * BM + bj * HALF + wc * 32 + 8 * fq);
                        const f32x4 b0 = *(const f32x4*)(base + off), b1 = *(const f32x4*)(base + off + 4);
                        const f32x4 h0 = b0 + acc[ai][bj][m][0] * alpha, h1 = b1 + acc[ai][bj][m][1] * alpha;
                        *(f32x4*)(outf + off) = h0; *(f32x4*)(outf + off + 4) = h1;
                        if (O != nullptr) *(u32x4*)(O + off) = pack8(h0, h1);
                        s += (h0[0] * h0[0] + h0[1] * h0[1]) + (h0[2] * h0[2] + h0[3] * h0[3]) + (h1[0] * h1[0] + h1[1] * h1[1]) + (h1[2] * h1[2] + h1[3] * h1[3]); }
                    s += __shfl_xor(s, 16); s += __shfl_xor(s, 32);
                    if (fq == 0) ssq_out[(unsigned)(r * 16 + u.pn * 4 + wc)] = s;
                    asm volatile("" ::: "memory"); }
        } else if constexpr (MODE == 7) {
#pragma unroll
            for (int ai = 0; ai < 2; ++ai)
#pragma unroll
                for (int m = 0; m < 4; ++m) { const int r = row0 + ai * HALF + m * 16;
#pragma unroll
                    for (int bj = 0; bj < 2; ++bj) { const int hh = 2 * u.pn + bj; const f32x4 v0 = acc[ai][bj][m][0], v1 = acc[ai][bj][m][1];
                        if (wc < 2) *(u32x4*)(O + (unsigned)(r * 512 + hh * 64 + wc * 32 + 8 * fq)) = pack8(v0, v1);
                        else { bf16_t* vt = O2 + (unsigned)((((r >> 13) * 8 + hh) * 64 + (wc - 2) * 32 + 8 * fq) * 8192 + (r & 8191));
#pragma unroll
                            for (int e = 0; e < 4; ++e) { vt[(unsigned)(e * 8192)] = (bf16_t)(cvt_pk_bf16(v0[e], 0.f) & 0xffffu); vt[(unsigned)((4 + e) * 8192)] = (bf16_t)(cvt_pk_bf16(v1[e], 0.f) & 0xffffu); } } } }
        } else {
            int colt = u.pn * BM; bf16_t* ob = O; int ld = ldc;
            if (MODE == 0 && colt >= split) { ob = O2; ld = ldc2; colt -= split; }
            if (MODE == 0 && colt >= 1024) {
                bf16_t* VT = (bf16_t*)G;
#pragma unroll
                for (int ai = 0; ai < 2; ++ai)
#pragma unroll
                    for (int m = 0; m < 4; ++m) { const int r = row0 + ai * HALF + m * 16; const float sc = __builtin_amdgcn_rsqf(row_ssq(ssq, r) * inv_n + RMS_EPS);
#pragma unroll
                        for (int bj = 0; bj < 2; ++bj) { const f32x4 v0 = acc[ai][bj][m][0] * sc, v1 = acc[ai][bj][m][1] * sc;
                            bf16_t* vt = VT + (unsigned)(((r >> 13) * 512 + (colt - 1024) + bj * HALF + wc * 32 + 8 * fq) * 8192 + (r & 8191));
#pragma unroll
                            for (int e = 0; e < 4; ++e) { vt[(unsigned)(e * 8192)] = (bf16_t)(cvt_pk_bf16(v0[e], 0.f) & 0xffffu); vt[(unsigned)((4 + e) * 8192)] = (bf16_t)(cvt_pk_bf16(v1[e], 0.f) & 0xffffu); } } }
                return;
            }
            const int col0 = colt + wc * 32 + 8 * fq, gcol0 = u.pn * BM + wc * 32 + 8 * fq;
            f32x4 bv[2][2], sv[2][2];
            if constexpr (MODE == 3) {
#pragma unroll
                for (int bj = 0; bj < 2; ++bj)
#pragma unroll
                    for (int n = 0; n < 2; ++n) { bv[bj][n] = *(const f32x4*)(bias + gcol0 + bj * HALF + 4 * n); sv[bj][n] = *(const f32x4*)(scale + gcol0 + bj * HALF + 4 * n); }
            }
#pragma unroll
            for (int ai = 0; ai < 2; ++ai)
#pragma unroll
                for (int m = 0; m < 4; ++m) { const int r = row0 + ai * HALF + m * 16;
                    float sc = 1.f; if (MODE == 0 || MODE == 4) sc = __builtin_amdgcn_rsqf(row_ssq(ssq, r) * inv_n + RMS_EPS);
#pragma unroll
                    for (int bj = 0; bj < 2; ++bj) { f32x4 v0 = acc[ai][bj][m][0], v1 = acc[ai][bj][m][1]; bf16_t* p = ob + (unsigned)(r * ld + col0 + bj * HALF);
                        if constexpr (MODE == 0) { v0 = v0 * sc; v1 = v1 * sc; }
                        if constexpr (MODE == 3) { v0 = (v0 + bv[bj][0]) * sv[bj][0]; v1 = (v1 + bv[bj][1]) * sv[bj][1]; }
                        if constexpr (MODE == 4) {
#pragma unroll
                            for (int e = 0; e < 4; ++e) { v0[e] = sigmoid_f(v0[e] * sc); v1[e] = sigmoid_f(v1[e] * sc); } }
                        if constexpr (MODE == 5) { const u32x4 g = *(const u32x4*)(G + (unsigned)(r * ld + col0 + bj * HALF));
                            v0 = v0 * (f32x4){bf_lo(g.x), bf_hi(g.x), bf_lo(g.y), bf_hi(g.y)}; v1 = v1 * (f32x4){bf_lo(g.z), bf_hi(g.z), bf_lo(g.w), bf_hi(g.w)};
                            if (!first) { const u32x4 q = *(const u32x4*)p; v0 = v0 + (f32x4){bf_lo(q.x), bf_hi(q.x), bf_lo(q.y), bf_hi(q.y)}; v1 = v1 + (f32x4){bf_lo(q.z), bf_hi(q.z), bf_lo(q.w), bf_hi(q.w)}; } }
                        *(u32x4*)p = pack8(v0, v1); }
                    if (MODE == 5 || MODE == 4) asm volatile("" ::: "memory"); }
        }
    }
};
template <class Epi, class Sched, bool ALIGN_EPI = false, bool SP2 = false>
__device__ __forceinline__ void gemm_phase(PG8_LAS unsigned char* lds, const Gemm g, const Sched& S, const Epi& E) {
    int tid_l = threadIdx.x; asm volatile("" : "+v"(tid_l));
    const int tid = tid_l, wid = __builtin_amdgcn_readfirstlane(tid >> 6), lane = tid & 63, wr = wid >> 2, wc = wid & 3, fr = lane & 15, fq = lane >> 4;
    const int K = g.K, nt = K / BK;
    unsigned voffA[2], voffB[2];
#pragma unroll
    for (int i = 0; i < 2; ++i) { int R, C; stage_rc(tid * 16 + i * 8192, R, C); const int Rb = Epi::PERM ? ((R & ~31) + perm32(R & 31)) : R;
        voffA[i] = (unsigned)(R * K + C) * 2u; voffB[i] = (unsigned)(Rb * K + C) * 2u; }
    const size_t kstep = (size_t)(BK * 2);
    const size_t hstep = (size_t)HALF * K * 2;
    const size_t tstep = 2 * hstep;
    const unsigned ldsw = (unsigned)wid * 1024u;
    const int aoff = lds_byte(wr * 64 + fr, fq * 8), boff = lds_byte(wc * 32 + fr, fq * 8);
#define PG8_SA(b, h) (((b) * 2 + (h)) * HTB)
#define PG8_SB(b, h) ((4 + (b) * 2 + (h)) * HTB)
#define PG8_STAGE(bufoff, gbase, voff) do { _Pragma("unroll") for (int _i = 0; _i < 2; ++_i) \
        __builtin_amdgcn_global_load_lds((const unsigned*)((const char*)(gbase) + (voff)[_i]), (PG8_LAS unsigned*)(lds + (bufoff) + ldsw + _i * 8192), 16, 0, 0); } while (0)
#define PG8_LDA(dst, b, h) do { _Pragma("unroll") for (int m = 0; m < 4; ++m) _Pragma("unroll") for (int k = 0; k < 2; ++k) dst[m][k] = *(const PG8_LAS bf16x8*)(lds + PG8_SA(b, h) + aoff + m * 2048 + k * 1024); } while (0)
#define PG8_LDB(dst, b, h) do { _Pragma("unroll") for (int n = 0; n < 2; ++n) _Pragma("unroll") for (int k = 0; k < 2; ++k) dst[n][k] = *(const PG8_LAS bf16x8*)(lds + PG8_SB(b, h) + boff + n * 2048 + k * 1024); } while (0)
#define PG8_MMA(ai, bj, At, Bt) do { __builtin_amdgcn_s_setprio(1); _Pragma("unroll") for (int m = 0; m < 4; ++m) _Pragma("unroll") for (int n = 0; n < 2; ++n) _Pragma("unroll") for (int k = 0; k < 2; ++k) \
        acc[ai][bj][m][n] = __builtin_amdgcn_mfma_f32_16x16x32_bf16(Bt[n][k], At[m][k], acc[ai][bj][m][n], 0, 0, 0); __builtin_amdgcn_s_setprio(0); } while (0)
#define PG8_WAIT_V(n) asm volatile("s_waitcnt vmcnt(" #n ")" ::: "memory")
#define PG8_WAIT_L(n) asm volatile("s_waitcnt lgkmcnt(" #n ")" ::: "memory")
#define PG8_BAR __builtin_amdgcn_s_barrier()
#define PG8_SCHED __builtin_amdgcn_sched_barrier(0)
    Unit cur, nxt; int ui = 0;
    if (!S.next(0, cur)) return;
    f32x4 acc[2][2][4][2];
#pragma unroll
    for (int a = 0; a < 2; ++a)
#pragma unroll
        for (int b = 0; b < 2; ++b)
#pragma unroll
            for (int m = 0; m < 4; ++m)
#pragma unroll
                for (int n = 0; n < 2; ++n) acc[a][b][m][n] = (f32x4){0.f, 0.f, 0.f, 0.f};
    bf16x8 At[4][2], B0[2][2], B1[2][2];
    const char* cA = (const char*)g.A + (size_t)cur.pm * tstep; const char* cB = (const char*)g.Bt + (size_t)cur.pn * tstep;
    S.a_ready(cur);
    if constexpr (SP2) {
        PG8_STAGE(PG8_SB(0, 0), cB, voffB); PG8_STAGE(PG8_SB(0, 1), cB + hstep, voffB); PG8_STAGE(PG8_SA(0, 0), cA, voffA); PG8_STAGE(PG8_SA(0, 1), cA + hstep, voffA);
        if (wr == 1) PG8_BAR;
        PG8_WAIT_V(2); PG8_BAR;
        PG8_STAGE(PG8_SB(1, 0), cB + kstep, voffB); PG8_STAGE(PG8_SA(1, 0), cA + kstep, voffA); PG8_STAGE(PG8_SB(1, 1), cB + hstep + kstep, voffB);
        PG8_WAIT_V(6); PG8_BAR;
    } else {
        PG8_STAGE(PG8_SB(0, 0), cB, voffB); PG8_STAGE(PG8_SA(0, 0), cA, voffA); PG8_STAGE(PG8_SB(0, 1), cB + hstep, voffB); PG8_STAGE(PG8_SA(0, 1), cA + hstep, voffA);
        if (wr == 1) PG8_BAR;
        PG8_WAIT_V(4); PG8_BAR;
        PG8_STAGE(PG8_SB(1, 0), cB + kstep, voffB); PG8_STAGE(PG8_SA(1, 0), cA + kstep, voffA); PG8_STAGE(PG8_SB(1, 1), cB + hstep + kstep, voffB);
        PG8_WAIT_V(6); PG8_BAR;
    }
    for (;;) {
        const bool has_next = S.next(ui + 1, nxt);
        const char* nA = has_next ? (const char*)g.A + (size_t)nxt.pm * tstep : cA; const char* nB = has_next ? (const char*)g.Bt + (size_t)nxt.pn * tstep : cB;
        for (int t = 0; t < nt; t += 2) {
            const bool last = (t == nt - 2);
            const char* a1 = cA + (size_t)(t + 1) * kstep;
            const char* a2 = last ? nA : cA + (size_t)(t + 2) * kstep; const char* b2 = last ? nB : cB + (size_t)(t + 2) * kstep;
            const char* a3 = a2 + kstep; const char* b3 = b2 + kstep;
            if (last && has_next) S.a_ready(nxt);
            if constexpr (SP2) {
            PG8_LDB(B0, 0, 0); PG8_LDB(B1, 0, 1); PG8_SCHED; PG8_LDA(At, 0, 0); PG8_STAGE(PG8_SA(1, 1), a1 + hstep, voffA);
            PG8_WAIT_V(8); PG8_WAIT_L(0); PG8_BAR; PG8_MMA(0, 0, At, B0); PG8_MMA(0, 1, At, B1); PG8_BAR; PG8_SCHED;
            PG8_LDA(At, 0, 1); PG8_STAGE(PG8_SB(0, 0), b2, voffB); PG8_STAGE(PG8_SB(0, 1), b2 + hstep, voffB); PG8_STAGE(PG8_SA(0, 0), a2, voffA);
            PG8_WAIT_V(8); PG8_WAIT_L(0); PG8_BAR; PG8_MMA(1, 0, At, B0); PG8_MMA(1, 1, At, B1); PG8_BAR; PG8_SCHED;
            PG8_LDB(B0, 1, 0); PG8_LDB(B1, 1, 1); PG8_SCHED; PG8_LDA(At, 1, 0); PG8_STAGE(PG8_SA(0, 1), a2 + hstep, voffA);
            PG8_WAIT_V(8); PG8_WAIT_L(0); PG8_BAR; PG8_MMA(0, 0, At, B0); PG8_MMA(0, 1, At, B1); PG8_BAR; PG8_SCHED;
            PG8_LDA(At, 1, 1); PG8_STAGE(PG8_SB(1, 0), b3, voffB); PG8_STAGE(PG8_SB(1, 1), b3 + hstep, voffB); PG8_STAGE(PG8_SA(1, 0), a3, voffA);
            PG8_WAIT_V(8); PG8_WAIT_L(0); PG8_BAR; PG8_MMA(1, 0, At, B0); PG8_MMA(1, 1, At, B1); PG8_BAR; PG8_SCHED;
            } else {
            PG8_LDB(B0, 0, 0); PG8_SCHED; PG8_LDA(At, 0, 0); PG8_STAGE(PG8_SA(1, 1), a1 + hstep, voffA);
            PG8_WAIT_L(8); PG8_BAR; PG8_WAIT_L(0); PG8_MMA(0, 0, At, B0); PG8_BAR; PG8_SCHED;
            PG8_LDB(B1, 0, 1); PG8_STAGE(PG8_SB(0, 0), b2, voffB);
            PG8_BAR; PG8_WAIT_L(0); PG8_MMA(0, 1, At, B1); PG8_BAR;
            PG8_LDA(At, 0, 1); PG8_STAGE(PG8_SA(0, 0), a2, voffA);
            PG8_BAR; PG8_WAIT_L(0); PG8_MMA(1, 0, At, B0); PG8_BAR; PG8_SCHED;
            PG8_STAGE(PG8_SB(0, 1), b2 + hstep, voffB);
            PG8_WAIT_V(6); PG8_BAR; PG8_MMA(1, 1, At, B1); PG8_BAR;
            PG8_LDB(B0, 1, 0); PG8_SCHED; PG8_LDA(At, 1, 0); PG8_STAGE(PG8_SA(0, 1), a2 + hstep, voffA);
            PG8_WAIT_L(8); PG8_BAR; PG8_WAIT_L(0); PG8_MMA(0, 0, At, B0); PG8_BAR; PG8_SCHED;
            PG8_LDB(B1, 1, 1); PG8_STAGE(PG8_SB(1, 0), b3, voffB);
            PG8_BAR; PG8_WAIT_L(0); PG8_MMA(0, 1, At, B1); PG8_BAR;
            PG8_LDA(At, 1, 1); PG8_STAGE(PG8_SA(1, 0), a3, voffA);
            PG8_BAR; PG8_WAIT_L(0); PG8_MMA(1, 0, At, B0); PG8_BAR; PG8_SCHED;
            PG8_STAGE(PG8_SB(1, 1), b3 + hstep, voffB);
            PG8_WAIT_V(6); PG8_BAR; PG8_MMA(1, 1, At, B1); PG8_BAR;
            }
        }
        if constexpr (ALIGN_EPI) { if (wr == 0) PG8_BAR; }
        if constexpr (!Epi::AFTER_DRAIN) { E(acc, cur, wr, wc, fr, fq); S.done(cur); }
        if (!has_next) break;
#pragma unroll
        for (int a = 0; a < 2; ++a)
#pragma unroll
            for (int b = 0; b < 2; ++b)
#pragma unroll
                for (int m = 0; m < 4; ++m)
#pragma unroll
                    for (int n = 0; n < 2; ++n) acc[a][b][m][n] = (f32x4){0.f, 0.f, 0.f, 0.f};
        cur = nxt; cA = nA; cB = nB; ++ui;
        if constexpr (ALIGN_EPI) { if (wr == 1) PG8_BAR; }
    }
    PG8_WAIT_V(0);
    if constexpr (!ALIGN_EPI) { if (wr == 0) PG8_BAR; }
    PG8_BAR;
    if constexpr (Epi::AFTER_DRAIN) { E.fused(acc, cur, wr, wc, fr, fq, lds, wid, lane); S.done(cur); }
#undef PG8_SA
#undef PG8_SB
#undef PG8_STAGE
#undef PG8_LDA
#undef PG8_LDB
#undef PG8_MMA
#undef PG8_WAIT_V
#undef PG8_WAIT_L
#undef PG8_BAR
#undef PG8_SCHED
}
}
constexpr int NB = 2, SEQ = 8192, DM = 1024, TT = NB * SEQ, DFF = 2816, NLAYER = 2;
constexpr int NWAVES = 8, NTHR = 512;
typedef unsigned short bf16;
typedef float f32x4 __attribute__((ext_vector_type(4)));
typedef float f32x16 __attribute__((ext_vector_type(16)));
typedef short bf16x8 __attribute__((ext_vector_type(8)));
typedef unsigned u32x4 __attribute__((ext_vector_type(4)));
typedef unsigned u32x2 __attribute__((ext_vector_type(2)));
#define LAS __attribute__((address_space(3)))
#define GAS __attribute__((address_space(1)))
using pg8::cvt_pk_bf16; using pg8::bf_lo; using pg8::bf_hi;

constexpr size_t MiB = 1u << 20;
constexpr size_t WS_SSQ = 249 * MiB;
constexpr size_t WS_WGU1 = 1 * MiB, WS_WD1 = 12 * MiB, WS_WIN = 17 * MiB + 512 * 1024, WS_WG = 22 * MiB + 512 * 1024;
constexpr size_t WS_WUQ = 28 * MiB + 512 * 1024, WS_WUKV = WS_WUQ + 384 * 1024, WS_WPOOL = WS_WUKV + 256 * 1024, WS_WB = WS_WPOOL + 512 * 1024;
constexpr size_t WS_WOUT = WS_WB + 3 * MiB, WS_WGU2 = WS_WOUT + 2 * MiB, WS_WD2 = WS_WGU2 + 11 * MiB;
static_assert(WS_WD2 + (size_t)DM * DFF * 2 <= 52 * MiB, "weights");
constexpr size_t WS_HB = 52 * MiB;
constexpr size_t WS_HID = 84 * MiB;
constexpr size_t WS_Z1 = 84 * MiB, WS_Z2 = 116 * MiB, WS_VTD = 148 * MiB;
constexpr size_t WS_CQN = 164 * MiB, WS_CKVN = 172 * MiB, WS_KR = 176 * MiB, WS_POOLED = 177 * MiB;
constexpr size_t WS_QM = 193 * MiB, WS_KN = 217 * MiB, WS_VTM = 233 * MiB;
constexpr size_t WS_YPOOL = 84 * MiB, WS_OM = 100 * MiB, WS_OD = 177 * MiB;
constexpr size_t WS_GT = 193 * MiB, WS_MB = 116 * MiB;
constexpr size_t WS_ATTQ = 14336;
constexpr size_t WS_KMAX = 51 * MiB + 256 * 1024;
constexpr size_t WS_POSFLAG = 15360;
constexpr size_t WS_TAB = 768 * 1024;
constexpr size_t WS_END = 256 * MiB;

constexpr size_t WS_BAR = 0, BAR_ZERO_BYTES = 16384;
constexpr int LDS_BYTES = 147456, LDS_MISC = 131072 + 1024;

struct Args { const float* in[27]; float* out; unsigned char* ws; float invf[16]; float lam_init[2]; int ph_lo, ph_hi; unsigned short order[1024]; };
static_assert(sizeof(Args) == 29 * 8 + 18 * 4 + 8 + 2048, "Args has no padding");

__device__ __forceinline__ float wave_sum(float v) {
#pragma unroll
    for (int o = 1; o < 64; o <<= 1) v += __shfl_xor(v, o);
    return v;
}
__device__ __forceinline__ void sincos_acc(float ang, float& s, float& c) {
    double rev = (double)ang * 0.15915494309189535; rev -= __builtin_rint(rev); const float fr = (float)rev;
    s = __builtin_amdgcn_sinf(fr); c = __builtin_amdgcn_cosf(fr);
}

__device__ __forceinline__ void transpose_item(const float* W, int N, const float* gain, bf16* WT, int ldt, int k0, int n0, int drow, LAS float* scr, int lane) {
    const int kq = lane >> 3, n4 = (lane & 7) * 4;
#pragma unroll
    for (int i = 0; i < 8; ++i) { const int kk = kq + 8 * i; f32x4 v = *(const f32x4*)(W + (size_t)(k0 + kk) * N + n0 + n4); if (gain) v = v * gain[k0 + kk];
        LAS float* sp = scr + kk * 33 + n4; sp[0] = v.x; sp[1] = v.y; sp[2] = v.z; sp[3] = v.w; }
    asm volatile("s_waitcnt lgkmcnt(0)" ::: "memory");
    const int c = lane & 7;
#pragma unroll
    for (int j = 0; j < 4; ++j) { const int n = (lane >> 3) + 8 * j; const LAS float* s = scr + (8 * c) * 33 + n;
        u32x4 o; o.x = cvt_pk_bf16(s[0 * 33], s[1 * 33]); o.y = cvt_pk_bf16(s[2 * 33], s[3 * 33]); o.z = cvt_pk_bf16(s[4 * 33], s[5 * 33]); o.w = cvt_pk_bf16(s[6 * 33], s[7 * 33]);
        *(u32x4*)(WT + (size_t)(drow + n) * ldt + k0 + 8 * c) = o; }
    asm volatile("s_waitcnt lgkmcnt(0)" ::: "memory");
}
template <int MAP> __device__ __forceinline__ void conv_matrix(const float* W, int K, int N, const float* gain, bf16* WT, int& base, int gw, int NGW, LAS float* scr, int lane) {
    const int nblk = N / 32, nitems = (K / 64) * nblk;
    int first = (gw - base) % NGW; if (first < 0) first += NGW;
    for (int it = first; it < nitems; it += NGW) {
        const int kb = it / nblk, nb = it % nblk, n0 = 32 * nb; int drow = n0;
        if (MAP == 1) drow = (n0 >> 7) * 256 + (n0 & 127);
        if (MAP == 2) drow = (n0 >> 7) * 256 + 128 + (n0 & 127);
        if (MAP == 3) drow = n0 < 416 ? n0 : (n0 < 1952 ? n0 - 416 + 1024 : (n0 < 2464 ? n0 - 1952 + 512 : n0 + 96));
        transpose_item(W, N, gain, WT, K, 64 * kb, n0, drow, scr, lane);
    }
    base = (base + nitems) % NGW;
}

namespace att {
constexpr int VP = 136, VB = 64 * VP;
template <int MODE> struct Cfg { static constexpr int DQK = MODE == 0 ? 96 : 64, NQ = DQK / 16, KP = DQK * 2 + 16, KB = 64 * KP, BUF = KB + VB + 256; };
struct P { const bf16* Q; int qpitch; const bf16* K; int kpitch; const bf16* KR; const bf16* V; int vpitch; bf16* O; const int* pos; const float* invf;
           const float* subln; float lam_init; float lam; const float* kmax; int nblk; };
#define MFMA32(a, b, c) __builtin_amdgcn_mfma_f32_32x32x16_bf16((a), (b), (c), 0, 0, 0)
__device__ __forceinline__ int crow(int r, int hi) { return (r & 3) + 8 * (r >> 2) + 4 * hi; }
__device__ __forceinline__ bf16x8 pack_frag(const f32x16& p, int s) {
    u32x4 w; w.x = cvt_pk_bf16(p[8 * s + 0], p[8 * s + 1]); w.y = cvt_pk_bf16(p[8 * s + 2], p[8 * s + 3]); w.z = cvt_pk_bf16(p[8 * s + 4], p[8 * s + 5]); w.w = cvt_pk_bf16(p[8 * s + 6], p[8 * s + 7]);
    return __builtin_bit_cast(bf16x8, w);
}
__device__ __forceinline__ float max16(const f32x16& a) {
    float m0 = fmaxf(fmaxf(a[0], a[1]), fmaxf(a[2], a[3])), m1 = fmaxf(fmaxf(a[4], a[5]), fmaxf(a[6], a[7]));
    float m2 = fmaxf(fmaxf(a[8], a[9]), fmaxf(a[10], a[11])), m3 = fmaxf(fmaxf(a[12], a[13]), fmaxf(a[14], a[15]));
    return fmaxf(fmaxf(m0, m1), fmaxf(m2, m3));
}
__device__ __forceinline__ int imax16(const f32x16& a) {
#define FI(i) __float_as_int(a[i])
    const int m0 = max(max(FI(0), FI(1)), FI(2)), m1 = max(max(FI(3), FI(4)), FI(5)), m2 = max(max(FI(6), FI(7)), FI(8)), m3 = max(max(FI(9), FI(10)), FI(11)), m4 = max(max(FI(12), FI(13)), FI(14));
    return max(max(max(m0, m1), m2), max(max(m3, m4), FI(15)));
#undef FI
}
__device__ __forceinline__ float sum16(const f32x16& a) {
    return ((a[0] + a[1]) + (a[2] + a[3])) + ((a[4] + a[5]) + (a[6] + a[7])) + ((a[8] + a[9]) + (a[10] + a[11])) + ((a[12] + a[13]) + (a[14] + a[15]));
}
template <bool SUM> __device__ __forceinline__ bool softmax_tile(f32x16& pa, f32x16& pb, float& m, float& l, f32x16& o0, f32x16& o1, bool first) {
    float rm;
    if (first) { rm = fmaxf(max16(pa), max16(pb)); rm = fmaxf(rm, __shfl_xor(rm, 32)); }
    else { int im = max(imax16(pa), imax16(pb));
        const auto rr = __builtin_amdgcn_permlane32_swap((unsigned)im, (unsigned)im, false, false); im = max((int)rr[0], (int)rr[1]); rm = __int_as_float(im); }
    bool moved = false;
    if (first || __any(rm > 8.0f)) {
        asm volatile("" ::: "memory");
        const float dl = first ? rm : fmaxf(rm, 0.f); m += dl; moved = true;
        if (!first) { const float f = __builtin_amdgcn_exp2f(-dl); l *= f;
#pragma unroll
            for (int r = 0; r < 16; ++r) { o0[r] *= f; o1[r] *= f; } }
#pragma unroll
        for (int r = 0; r < 16; ++r) { pa[r] -= dl; pb[r] -= dl; }
    }
#pragma unroll
    for (int r = 0; r < 16; ++r) { pa[r] = __builtin_amdgcn_exp2f(pa[r]); pb[r] = __builtin_amdgcn_exp2f(pb[r]); }
    if (SUM) l += sum16(pa) + sum16(pb);
    return moved;
}

__device__ __forceinline__ void split3_bf16(float x, unsigned& h1, unsigned& h2, unsigned& h3) {
    h1 = cvt_pk_bf16(x, 0.f) & 0xffffu; const float r1 = x - bf_lo(h1); h2 = cvt_pk_bf16(r1, 0.f) & 0xffffu; const float r2 = r1 - bf_lo(h2); h3 = cvt_pk_bf16(r2, 0.f) & 0xffffu;
}
template <int MODE, bool FAST = false> __device__ __forceinline__ void attn_pass(LAS unsigned char* lds, const bf16x8 (&qr)[MODE == 0 ? 6 : 4], const bf16* kb_g, int kpitch, const bf16* kr_g,
                                                              const bf16* vb_g, int vpitch, const int* posb, float pqf, float slope2, float bq0, float bq1, int q0, int qrow, int w,
                                                              f32x16 (&o)[MODE == 0 ? 1 : 2][2], float (&l)[MODE == 0 ? 1 : 2]) {
    constexpr int NM = MODE == 0 ? 1 : 2, NQ = MODE == 0 ? 6 : 2, KP = (MODE == 0 ? 192 : 128) + 16, KB = 64 * KP, BUF = KB + VB + 256;
    int tid_l = threadIdx.x; asm volatile("" : "+v"(tid_l));
    const int tid = tid_l, lane = tid & 63, r32 = lane & 31, hi = lane >> 5;
    const int skey = tid >> 3, sch = tid & 7, skey2 = tid >> 2, sch2 = tid & 3;
    const GAS bf16* ksrc = (const GAS bf16*)(kb_g + (unsigned)(skey * kpitch + sch * 8));
    const GAS bf16* vsrc = (const GAS bf16*)(vb_g + (unsigned)(skey * SEQ + sch * 8));
    const GAS bf16* krsrc = (const GAS bf16*)(kr_g + (unsigned)(skey2 * 32 + sch2 * 8));
    const GAS int* posg = (const GAS int*)posb;
    u32x4 kreg, vreg, krreg = {0u, 0u, 0u, 0u}; float pkreg = 0.f;
    const int NT = (q0 + 256) / 64, ntw = (q0 + 32 * w) / 64 + 1;
    constexpr bool REV = (MODE == 1) && FAST;
    int wdone = 0;
#define ATT_LOAD(t) do { vreg = *(const GAS u32x4*)(vsrc + (unsigned)((t) * 64)); kreg = *(const GAS u32x4*)(ksrc + (unsigned)((t) * 64 * kpitch)); \
        if (MODE == 0) { if (tid < 256) krreg = *(const GAS u32x4*)(krsrc + (unsigned)((t) * 64 * 32)); } \
        else { if (tid < 64) pkreg = (float)posg[(t) * 64 + tid]; } } while (0)
#define ATT_STORE(bufi) do { LAS unsigned char* sb = lds + (bufi) * BUF; *(LAS u32x4*)(sb + skey * KP + sch * 16) = kreg; \
        if (MODE == 0) { if (tid < 256) *(LAS u32x4*)(sb + skey2 * KP + 128 + sch2 * 16) = krreg; } \
        else { if (tid < 64) *(LAS float*)(sb + KB + VB + tid * 4) = pkreg; } \
        LAS u32x2* vt = (LAS u32x2*)(sb + KB + skey * VP + sch * 16); vt[0] = (u32x2){vreg.x, vreg.y}; vt[1] = (u32x2){vreg.z, vreg.w}; } while (0)
    float m[NM];
    f32x16 negm, lsum;
#pragma unroll
    for (int r = 0; r < 16; ++r) { negm[r] = 0.f; lsum[r] = 0.f; }
#pragma unroll
    for (int i = 0; i < NM; ++i) { m[i] = 0.f; l[i] = (MODE == 0) ? 1.0f : 0.f;
#pragma unroll
        for (int r = 0; r < 16; ++r) { o[i][0][r] = 0.f; o[i][1][r] = 0.f; } }
    bf16x8 qx[2];
    if constexpr (MODE == 1 && FAST) { unsigned s1, s2, s3; split3_bf16(slope2, s1, s2, s3);
        const unsigned e1 = cvt_pk_bf16(bf_lo(s1) * 64.0f, bf_lo(s2) * 64.0f), e2 = (cvt_pk_bf16(bf_lo(s3) * 64.0f, 0.f) & 0xffffu) | (s1 << 16), e3 = s2 | (s3 << 16);
        const u32x4 qv = {hi ? 0u : e1, hi ? 0u : e2, hi ? 0u : e3, 0u}; qx[0] = __builtin_bit_cast(bf16x8, qv); qx[1] = qx[0]; }
    ATT_LOAD(REV ? NT - 1 : 0); ATT_STORE(0); __syncthreads();
    for (int it = 0; it < NT; ++it) {
        const int t = REV ? NT - 1 - it : it; const bool first_t = REV ? (t == ntw - 1) : (t == 0);
        if (it + 1 < NT) ATT_LOAD(REV ? t - 1 : t + 1);
        if (t < ntw && !wdone) {
            LAS unsigned char* bb = lds + (it & 1) * BUF;
            const LAS unsigned char* kb = bb + r32 * KP + 16 * hi;
            bf16x8 kf[NM][2][NQ];
            f32x16 dist[2];
            bf16x8 kx[2];
            if constexpr (MODE == 1 && !FAST) {
                const LAS float* pk = (const LAS float*)(bb + KB + VB);
#pragma unroll
                for (int hf = 0; hf < 2; ++hf)
#pragma unroll
                    for (int g = 0; g < 4; ++g) { const f32x4 pk4 = *(const LAS f32x4*)(pk + 32 * hf + 8 * g + 4 * hi);
#pragma unroll
                        for (int e = 0; e < 4; ++e) dist[hf][4 * g + e] = pqf - pk4[e]; }
            }
            if constexpr (MODE == 1 && FAST) {
                const LAS float* pk = (const LAS float*)(bb + KB + VB);
#pragma unroll
                for (int hf = 0; hf < 2; ++hf) { const float pv = pk[32 * hf + r32]; const float a = __builtin_floorf(pv * 0.015625f), bq = __builtin_fmaf(-64.0f, a, pv);
                    const unsigned aa = cvt_pk_bf16(a, a), ab = cvt_pk_bf16(a, bq), bb2 = cvt_pk_bf16(bq, bq);
                    const u32x4 kv = {hi ? 0x3f803f80u : aa, hi ? 0x00003f80u : ab, hi ? 0u : bb2, 0u}; kx[hf] = __builtin_bit_cast(bf16x8, kv); }
            }
            bf16x8 pf[NM][4];
#pragma unroll
            for (int mp = 0; mp < NM; ++mp) {
                f32x16 p[2];
#pragma unroll
                for (int hf = 0; hf < 2; ++hf)
#pragma unroll
                    for (int d = 0; d < NQ; ++d) kf[mp][hf][d] = *(const LAS bf16x8*)(kb + hf * 32 * KP + 32 * (mp * NQ + d));
                __builtin_amdgcn_sched_barrier(0);
                if constexpr (MODE == 1 && FAST) {
                    if (t == ntw - 1) {
                        int tt = t; asm volatile("" : "+s"(tt));
                        const float tb = (float)(qrow - 64 * tt - 4 * hi);
#pragma unroll
                        for (int hf = 0; hf < 2; ++hf) { f32x16 c;
#pragma unroll
                            for (int r = 0; r < 16; ++r) c[r] = fminf(tb - (float)(32 * hf + (r & 3) + 8 * (r >> 2)), 0.f) * 1e30f;
                            p[hf] = MFMA32(kx[hf], qx[mp], c); }
                    } else {
                        const f32x16 z16 = {0.f, 0.f, 0.f, 0.f, 0.f, 0.f, 0.f, 0.f, 0.f, 0.f, 0.f, 0.f, 0.f, 0.f, 0.f, 0.f};
#pragma unroll
                        for (int hf = 0; hf < 2; ++hf) p[hf] = MFMA32(kx[hf], qx[mp], z16);
                    }
#pragma unroll
                    for (int hf = 0; hf < 2; ++hf)
#pragma unroll
                        for (int d = 0; d < NQ; ++d) p[hf] = MFMA32(kf[mp][hf][d], qr[mp * NQ + d], p[hf]);
                } else if constexpr (MODE == 1) {
#pragma unroll
                    for (int hf = 0; hf < 2; ++hf)
#pragma unroll
                        for (int r = 0; r < 16; ++r) p[hf][r] = __builtin_fmaf(-slope2, __builtin_fabsf(dist[hf][r]), -m[mp]);
                    if (t == ntw - 1) {
                        int tt = t; asm volatile("" : "+s"(tt));
                        const float tb = (float)(qrow - 64 * tt - 4 * hi);
#pragma unroll
                        for (int hf = 0; hf < 2; ++hf)
#pragma unroll
                            for (int r = 0; r < 16; ++r) p[hf][r] += fminf(tb - (float)(32 * hf + (r & 3) + 8 * (r >> 2)), 0.f) * 1e30f;
                    }
#pragma unroll
                    for (int hf = 0; hf < 2; ++hf)
#pragma unroll
                        for (int d = 0; d < NQ; ++d) p[hf] = MFMA32(kf[mp][hf][d], qr[mp * NQ + d], p[hf]);
                } else {
                    if (t == ntw - 1) {
                        int tt = t; asm volatile("" : "+s"(tt));
                        const float tb = (float)(qrow - 64 * tt - 4 * hi);
#pragma unroll
                        for (int hf = 0; hf < 2; ++hf) { f32x16 c;
#pragma unroll
                            for (int r = 0; r < 16; ++r) c[r] = negm[r] + fminf(tb - (float)(32 * hf + (r & 3) + 8 * (r >> 2)), 0.f) * 1e30f;
                            p[hf] = MFMA32(kf[0][hf][0], qr[0], c); }
                    } else {
#pragma unroll
                        for (int hf = 0; hf < 2; ++hf) p[hf] = MFMA32(kf[0][hf][0], qr[0], negm);
                    }
#pragma unroll
                    for (int hf = 0; hf < 2; ++hf)
#pragma unroll
                        for (int d = 1; d < NQ; ++d) p[hf] = MFMA32(kf[0][hf][d], qr[d], p[hf]);
                }
                __builtin_amdgcn_sched_barrier(0);
                const float l_before = l[mp];
                const bool moved = softmax_tile<MODE == 1>(p[0], p[1], m[mp], l[mp], o[mp][0], o[mp][1], first_t);
                if constexpr (MODE == 1 && FAST) { if (moved) { unsigned h1, h2, h3; split3_bf16(-m[mp], h1, h2, h3);
                        if (hi) { const u32x4 qv = {h1 | (h2 << 16), h3, 0u, 0u}; qx[mp] = __builtin_bit_cast(bf16x8, qv); } } }
                if (MODE == 0 && moved) { const float f = first_t ? 0.f : l[0] / l_before;
#pragma unroll
                    for (int r = 0; r < 16; ++r) { negm[r] = -m[0]; lsum[r] *= f; } l[0] = 1.0f; }
#pragma unroll
                for (int ks = 0; ks < 4; ++ks) pf[mp][ks] = pack_frag(p[ks >> 1], ks & 1);
            }
            const LAS unsigned char* vb = bb + KB + r32 * VP + 8 * hi;
#pragma unroll
            for (int dh = 0; dh < 2; ++dh) {
                bf16x8 vf[4];
#pragma unroll
                for (int ks = 0; ks < 4; ++ks) {
                    const u32x2 v0 = *(const LAS u32x2*)(vb + dh * 32 * VP + 32 * ks), v1 = *(const LAS u32x2*)(vb + dh * 32 * VP + 32 * ks + 16);
                    const u32x4 vv = {v0.x, v0.y, v1.x, v1.y}; vf[ks] = __builtin_bit_cast(bf16x8, vv); }
                __builtin_amdgcn_sched_barrier(0);
#pragma unroll
                for (int ks = 0; ks < 4; ++ks)
#pragma unroll
                    for (int mp = 0; mp < NM; ++mp) o[mp][dh] = MFMA32(vf[ks], pf[mp][ks], o[mp][dh]);
                __builtin_amdgcn_sched_barrier(0);
            }
            if constexpr (MODE == 0) {
                const u32x4 o1 = {0x3f803f80u, 0x3f803f80u, 0x3f803f80u, 0x3f803f80u}; const bf16x8 ones = __builtin_bit_cast(bf16x8, o1);
#pragma unroll
                for (int ks = 0; ks < 4; ++ks) lsum = MFMA32(ones, pf[0][ks], lsum);
            }
        }
        if (it + 1 < NT) ATT_STORE((it + 1) & 1);
        if constexpr (REV) {
            if (!wdone && t <= ntw - 1 && t >= 1) { const float pkm = (float)posg[64 * (t - 1) + 63];
                const float v = fmaxf(bq0 - m[0], bq1 - m[NM - 1]) + slope2 * pkm; wdone = __all(v < -152.0f) ? 1 : 0; }
            if (__syncthreads_and(wdone)) break;
        } else __syncthreads();
    }
    if constexpr (MODE == 0) l[0] = 0.5f * lsum[0];
#undef ATT_LOAD
#undef ATT_STORE
}

template <int MODE, bool FAST = false> __device__ __forceinline__ void attn_unit(LAS unsigned char* lds, const P& A, int b, int h, int qb) {
    int tid_l = threadIdx.x; asm volatile("" : "+v"(tid_l));
    const int tid = tid_l, lane = tid & 63, r32 = lane & 31, hi = lane >> 5; const int w = __builtin_amdgcn_readfirstlane(tid >> 6);
    const int q0 = qb * 256, qrow = q0 + 32 * w + r32; const unsigned rowbase = (unsigned)b * SEQ;
    const float LOG2E = 1.4426950408889634f;
    f32x16 res[2];
    if constexpr (MODE == 0) {
        const float qscale = 0.10206207261596575f * LOG2E;
        bf16x8 qr[6];
        {
            const bf16* qs = A.Q + (size_t)(rowbase + qrow) * 768 + h * 96 + 8 * hi;
            u32x4 raw[6];
#pragma unroll
            for (int d0 = 0; d0 < 6; ++d0) raw[d0] = *(const u32x4*)(qs + 16 * d0);
            float x1[8], x2[8];
#pragma unroll
            for (int e = 0; e < 4; ++e) { x1[2 * e] = bf_lo(raw[4][e]); x1[2 * e + 1] = bf_hi(raw[4][e]); x2[2 * e] = bf_lo(raw[5][e]); x2[2 * e + 1] = bf_hi(raw[5][e]); }
            const float posf = (float)A.pos[rowbase + qrow];
#pragma unroll
            for (int e = 0; e < 8; ++e) { const float fq = A.invf[8 * hi + e]; float s, c; sincos_acc(posf * fq, s, c);
                const float a = x1[e], bb2 = x2[e]; x1[e] = (a * c - bb2 * s) * qscale; x2[e] = (bb2 * c + a * s) * qscale; }
#pragma unroll
            for (int d0 = 0; d0 < 4; ++d0) { u32x4 wv;
#pragma unroll
                for (int e = 0; e < 4; ++e) wv[e] = cvt_pk_bf16(bf_lo(raw[d0][e]) * qscale, bf_hi(raw[d0][e]) * qscale);
                qr[d0] = __builtin_bit_cast(bf16x8, wv); }
            u32x4 w4, w5;
#pragma unroll
            for (int e = 0; e < 4; ++e) { w4[e] = cvt_pk_bf16(x1[2 * e], x1[2 * e + 1]); w5[e] = cvt_pk_bf16(x2[2 * e], x2[2 * e + 1]); }
            qr[4] = __builtin_bit_cast(bf16x8, w4); qr[5] = __builtin_bit_cast(bf16x8, w5);
        }
        f32x16 o[1][2]; float l[1];
        attn_pass<0>(lds, qr, A.K + (size_t)rowbase * 512, 512, A.KR + (size_t)rowbase * 32, A.V + (size_t)(b * 8 + h) * 64 * SEQ, 0, nullptr, 0.f, 0.f, 0.f, 0.f, q0, qrow, w, o, l);
        const float inv = 1.0f / (l[0] + __shfl_xor(l[0], 32));
#pragma unroll
        for (int dh = 0; dh < 2; ++dh)
#pragma unroll
            for (int r = 0; r < 16; ++r) res[dh][r] = o[0][dh][r] * inv;
    } else {
        const float qscale = 0.17677669529663687f * LOG2E;
        const float pqf = (float)A.pos[rowbase + qrow], slope2 = __builtin_amdgcn_exp2f(-(float)(h + 1)) * LOG2E;
        const float lam = A.lam;
        bf16x8 qr[4];
        { const bf16* qs = A.Q + (size_t)(rowbase + qrow) * 1024 + h * 64 + 8 * hi;
#pragma unroll
          for (int d0 = 0; d0 < 4; ++d0) { const u32x4 raw = *(const u32x4*)(qs + 16 * d0); u32x4 wv;
#pragma unroll
              for (int e = 0; e < 4; ++e) wv[e] = cvt_pk_bf16(bf_lo(raw[e]) * qscale, bf_hi(raw[e]) * qscale);
              qr[d0] = __builtin_bit_cast(bf16x8, wv); } }
        float bq0 = 0.f, bq1 = 0.f;
        if constexpr (FAST) {
            float n0 = 0.f, n1 = 0.f;
#pragma unroll
            for (int d0 = 0; d0 < 4; ++d0) { const u32x4 qv = __builtin_bit_cast(u32x4, qr[d0]); float a = 0.f;
#pragma unroll
                for (int e = 0; e < 4; ++e) { const float x = bf_lo(qv[e]), y = bf_hi(qv[e]); a += x * x + y * y; }
                if (d0 < 2) n0 += a; else n1 += a; }
            n0 += __shfl_xor(n0, 32); n1 += __shfl_xor(n1, 32);
            float k0 = 0.f, k1 = 0.f; const float* km = A.kmax + (b * 16 + h * 2);
            for (int blk = lane; blk < A.nblk; blk += 64) { k0 = fmaxf(k0, km[blk * 32]); k1 = fmaxf(k1, km[blk * 32 + 1]); }
#pragma unroll
            for (int sft = 1; sft < 64; sft <<= 1) { k0 = fmaxf(k0, __shfl_xor(k0, sft)); k1 = fmaxf(k1, __shfl_xor(k1, sft)); }
            bq0 = 1.02f * sqrtf(n0 * k0) + 0.05f; bq1 = 1.02f * sqrtf(n1 * k1) + 0.05f;
        }
        f32x16 o[2][2]; float l[2];
        attn_pass<1, FAST>(lds, qr, A.K + (size_t)rowbase * 1024, 1024, nullptr, A.V + (size_t)(b * 8 + h) * 64 * SEQ, 0, A.pos + rowbase, pqf, slope2, bq0, bq1, q0, qrow, w, o, l);
        const float inv0 = 1.0f / (l[0] + __shfl_xor(l[0], 32)), inv1 = lam / (l[1] + __shfl_xor(l[1], 32));
        float ss = 0.f;
#pragma unroll
        for (int dh = 0; dh < 2; ++dh)
#pragma unroll
            for (int r = 0; r < 16; ++r) { const float v = o[0][dh][r] * inv0 - o[1][dh][r] * inv1; res[dh][r] = v; ss += v * v; }
        ss += __shfl_xor(ss, 32);
        const float rs = __builtin_amdgcn_rsqf(ss * (1.0f / 64.0f) + 1e-6f) * (1.0f - A.lam_init);
#pragma unroll
        for (int dh = 0; dh < 2; ++dh)
#pragma unroll
            for (int g = 0; g < 4; ++g) { const f32x4 sg = *(const f32x4*)(A.subln + 32 * dh + 8 * g + 4 * hi);
#pragma unroll
                for (int e = 0; e < 4; ++e) res[dh][4 * g + e] *= rs * sg[e]; }
    }
    bf16* orow = A.O + (size_t)(rowbase + qrow) * 512 + h * 64 + 4 * hi;
#pragma unroll
    for (int dh = 0; dh < 2; ++dh)
#pragma unroll
        for (int g = 0; g < 4; ++g) { u32x2 wv; wv.x = cvt_pk_bf16(res[dh][4 * g], res[dh][4 * g + 1]); wv.y = cvt_pk_bf16(res[dh][4 * g + 2], res[dh][4 * g + 3]);
            *(u32x2*)(orow + 32 * dh + 8 * g) = wv; }
}
}

#define XB_TMO      128
#define XB_XCNT(j)  (256  + 64 * (j))
#define XB_XSUB(j)  (1280 + 64 * (j))
#define XB_XGEN(j)  (2304 + 64 * (j))
#define XB_TOP      3328
#define XB_TOPGEN   3392
#define XCD_BAR_WORDS 3456
#define XB_SPIN_CAP (1u << 18)

__device__ __forceinline__ unsigned xb_ld(unsigned* p)              { return __hip_atomic_load(p, __ATOMIC_RELAXED, __HIP_MEMORY_SCOPE_AGENT); }
__device__ __forceinline__ unsigned xb_add(unsigned* p, unsigned v) { return __hip_atomic_fetch_add(p, v, __ATOMIC_RELAXED, __HIP_MEMORY_SCOPE_AGENT); }
__device__ __forceinline__ unsigned xb_xcc_id() { return (unsigned)__builtin_amdgcn_s_getreg((3 << 11) | 20) & 0xFu; }
#define XB_SPIN(cond, bar) do { unsigned _sp = 0; while (cond) { __builtin_amdgcn_s_sleep(1); \
    if ((++_sp & 255u) == 0u) { if (xb_ld(&(bar)[XB_TMO])) break; if (_sp > XB_SPIN_CAP) { atomicAdd(&(bar)[XB_TMO], 1u); break; } } } } while (0)

struct XcdBarrier {
    unsigned* bar; unsigned x;
    volatile LAS unsigned* st;
};

__device__ __forceinline__ XcdBarrier xcd_barrier_post(unsigned* bar, volatile LAS unsigned* st) {
    XcdBarrier b; b.bar = bar; b.x = xb_xcc_id(); b.st = st;
    if (threadIdx.x == 0) (void)xb_add(&bar[XB_XCNT(b.x)], 1u);
    return b;
}
__device__ __forceinline__ void xcd_barrier_complete(unsigned* bar, unsigned x, unsigned& nloc, unsigned& nx) {
    const unsigned G = gridDim.x * gridDim.y * gridDim.z;
    unsigned sum, cnt, mine, sp = 0u;
    for (;;) {
        sum = 0u; cnt = 0u; mine = 0u;
#pragma unroll
        for (unsigned j = 0; j < 16; ++j) { const unsigned c = xb_ld(&bar[XB_XCNT(j)]); sum += c; cnt += (c > 0u) ? 1u : 0u; mine = (j == x) ? c : mine; }
        if (sum == G) break;
        __builtin_amdgcn_s_sleep(1);
        if ((++sp & 255u) == 0u) { if (xb_ld(&bar[XB_TMO])) break; if (sp > XB_SPIN_CAP) { atomicAdd(&bar[XB_TMO], 1u); break; } }
    }
    nloc = mine > 0u ? mine : 1u; nx = cnt > 0u ? cnt : 1u;
}

__device__ __forceinline__ void xcd_barrier(const XcdBarrier& b) {
    asm volatile("s_waitcnt vmcnt(0)" ::: "memory");
    __syncthreads();
    if (threadIdx.x == 0) {
        unsigned* bar = b.bar;
        __builtin_amdgcn_s_waitcnt(0);
        unsigned nloc = b.st[0], nx = b.st[1];
        if (nloc == 0u) { xcd_barrier_complete(bar, b.x, nloc, nx); b.st[0] = nloc; b.st[1] = nx; }
        const unsigned old = xb_add(&bar[XB_XSUB(b.x)], 1u);
        const unsigned gen = old / nloc;
        if (old + 1u == (gen + 1u) * nloc) {
            __builtin_amdgcn_fence(__ATOMIC_RELEASE, "agent");
            asm volatile("s_waitcnt vmcnt(0)" ::: "memory");
            const unsigned og = xb_add(&bar[XB_TOP], 1u);
            const unsigned tg = og / nx;
            if (og + 1u == (tg + 1u) * nx) xb_add(&bar[XB_TOPGEN], 1u);
            else XB_SPIN(xb_ld(&bar[XB_TOPGEN]) == tg, bar);
            __builtin_amdgcn_fence(__ATOMIC_ACQUIRE, "agent");
            xb_add(&bar[XB_XGEN(b.x)], 1u);
            asm volatile("s_waitcnt vmcnt(0)" ::: "memory");
        } else {
            XB_SPIN(xb_ld(&bar[XB_XGEN(b.x)]) == gen, bar);
            __builtin_amdgcn_fence(__ATOMIC_ACQUIRE, "agent");
            asm volatile("s_waitcnt vmcnt(0)" ::: "memory");
        }
    }
    __syncthreads();
}
#ifndef ONLY
#define ONLY -1
#endif
#define EN(x) (ONLY < 0 || ONLY == (x))
__device__ __forceinline__ int opaque_i(int v) { asm volatile("" : "+s"(v)); return v; }
#define KL1 opaque_i(1024)
#define KL2 opaque_i(512)
#define KL3 opaque_i(256)
#define KL4 opaque_i(128)
#define KL5 opaque_i(DFF)
constexpr int PH_PER_LAYER = 11, N_PHASES = NLAYER * PH_PER_LAYER + 1;
__global__ void __launch_bounds__(NTHR) fwd_kernel(Args args) {
    extern __shared__ __attribute__((aligned(16))) unsigned char lds_raw[];
    LAS unsigned char* lds = (LAS unsigned char*)lds_raw;
    const int G0 = gridDim.x, bx0 = blockIdx.x;
    typedef const __attribute__((address_space(4))) Args KArgs;
    KArgs* const ap0 = (KArgs*)__builtin_amdgcn_kernarg_segment_ptr();
    unsigned char* const ws0 = args.ws;
    if (threadIdx.x < 2) ((volatile LAS unsigned*)(lds + LDS_MISC))[threadIdx.x] = 0u;
    __syncthreads();
    const bool use_bar = (args.ph_hi - args.ph_lo) > 1;
    XcdBarrier bar; bar.bar = (unsigned*)(ws0 + WS_BAR); bar.x = 0; bar.st = (volatile LAS unsigned*)(lds + LDS_MISC);
    if (use_bar) bar = xcd_barrier_post((unsigned*)(ws0 + WS_BAR), (volatile LAS unsigned*)(lds + LDS_MISC));
    const int lo = args.ph_lo, hi_ph = args.ph_hi;
    const bool multi = (hi_ph - lo) > 1;

    for (int ph = lo; ph < hi_ph; ++ph) {
        const int L = ph / PH_PER_LAYER, k = ph - L * PH_PER_LAYER;
        int tid = threadIdx.x; asm volatile("" : "+v"(tid)); const int lane = tid & 63, wave = __builtin_amdgcn_readfirstlane(tid >> 6);
        unsigned char* ws = ws0; asm volatile("" : "+s"(ws));
        int G = G0, bx = bx0; asm volatile("" : "+s"(G), "+s"(bx));
        const KArgs* ap = ap0; asm volatile("" : "+s"(ap));
        float* const ssq = (float*)(ws + WS_SSQ);   float* const hbuf = ap->out; bf16* const HB = (bf16*)(ws + WS_HB);
        const int vcu = (G % 8 == 0) ? (bx % 8) * (G / 8) + bx / 8 : bx;
        const int gw = vcu * NWAVES + wave, NGW = G * NWAVES;
        if (ph == N_PHASES - 1) {
            const float* gn = ap->in[26]; const float* sq = ssq + (size_t)(3 * NLAYER) * TT * 16;
            for (int row = gw; row < TT; row += NGW) {
                const float rs = __builtin_amdgcn_rsqf(pg8::row_ssq(sq, row) * (1.0f / DM) + 1e-6f);
                f32x4* xr = (f32x4*)(hbuf + (size_t)row * DM) + lane;
#pragma unroll
                for (int j = 0; j < 4; ++j) { const f32x4 v = xr[64 * j], gg = ((const f32x4*)gn)[lane + 64 * j]; xr[64 * j] = v * rs * gg; }
            }
        } else if (k == 0 && EN(0)) {
            LAS float* scr = (LAS float*)(lds + wave * 16384);
            int base = 0;
            for (int f = 0; f < 2; ++f) {
                const float* nrm = ap->in[f ? 22 : 2] + (size_t)L * DM; bf16* Wgu = (bf16*)(ws + (f ? WS_WGU2 : WS_WGU1));
                conv_matrix<1>(ap->in[f ? 23 : 3] + (size_t)L * DM * DFF, DM, DFF, nrm, Wgu, base, gw, NGW, scr, lane);
                conv_matrix<2>(ap->in[f ? 24 : 4] + (size_t)L * DM * DFF, DM, DFF, nrm, Wgu, base, gw, NGW, scr, lane);
                conv_matrix<0>(ap->in[f ? 25 : 5] + (size_t)L * DFF * DM, DFF, DM, nullptr, (bf16*)(ws + (f ? WS_WD2 : WS_WD1)), base, gw, NGW, scr, lane);
            }
            conv_matrix<3>(ap->in[7] + (size_t)L * DM * 5536, DM, 5536, ap->in[6] + (size_t)L * DM, (bf16*)(ws + WS_WIN), base, gw, NGW, scr, lane);
            conv_matrix<0>(ap->in[9] + (size_t)L * 256 * 768, 256, 768, nullptr, (bf16*)(ws + WS_WUQ), base, gw, NGW, scr, lane);
            conv_matrix<0>(ap->in[11] + (size_t)L * 128 * 1024, 128, 1024, nullptr, (bf16*)(ws + WS_WUKV), base, gw, NGW, scr, lane);
            for (int i = 0; i < 3; ++i) conv_matrix<0>(ap->in[20] + ((size_t)L * 3 + i) * 512 * 1024, 512, 1024, nullptr, (bf16*)(ws + WS_WB) + (size_t)i * 1024 * 512, base, gw, NGW, scr, lane);
            conv_matrix<0>(ap->in[21] + (size_t)L * DM * DM, DM, DM, nullptr, (bf16*)(ws + WS_WOUT), base, gw, NGW, scr, lane);
            const int gt = bx * NTHR + tid, ngt = G * NTHR;
            if (L == 0 && gt == 0) {
#pragma unroll
                for (int i = 0; i < 16; ++i) ((float*)(ws + WS_TAB))[i] = ap->invf[i]; }
            if (L == 0) {
                const int* posv = (const int*)ap->in[1]; bool bad = false;
                for (int i = gt; i < TT; i += ngt) { const int pv = posv[i]; bad |= (pv < 0) | (pv >= 16384); if ((i & (SEQ - 1)) != 0) bad |= (posv[i - 1] > pv); }
                if (bad) *(volatile unsigned*)(ws + WS_POSFLAG) = 1u; }
            { const float* pool_w = ap->in[17] + (size_t)L * 4 * 128 * 128; bf16* Wpool = (bf16*)(ws + WS_WPOOL);
              for (int i = gt; i < 512 * 512; i += ngt) { const int n = i >> 9, kk = i & 511; float v = 0.f; if ((n >> 7) == (kk >> 7)) v = pool_w[(size_t)(n >> 7) * 16384 + (kk & 127) * 128 + (n & 127)]; Wpool[i] = (bf16)(cvt_pk_bf16(v, 0.f) & 0xffffu); } }
            for (int i = gt; i < 96 * 1024 / 8; i += ngt) ((u32x4*)((bf16*)(ws + WS_WIN) + (size_t)416 * 1024))[i] = (u32x4){0u, 0u, 0u, 0u};
            if (L == 0) {
                const float* x = ap->in[0];
                for (int row = gw; row < TT; row += NGW) {
                    const f32x4* xr = (const f32x4*)(x + (size_t)row * DM) + lane; float s = 0.f;
#pragma unroll
                    for (int j = 0; j < 4; ++j) { const f32x4 v = xr[64 * j]; s += (v.x * v.x + v.y * v.y) + (v.z * v.z + v.w * v.w);
                        u32x2 o; o.x = cvt_pk_bf16(v.x, v.y); o.y = cvt_pk_bf16(v.z, v.w); ((u32x2*)(HB + (size_t)row * DM))[lane + 64 * j] = o; }
                    s = wave_sum(s); if (lane < 16) ssq[(size_t)row * 16 + lane] = lane == 0 ? s : 0.f;
                }
            }
        } else if ((k == 1 || k == 9) && EN(1)) {
            pg8::Gemm g{HB, (const bf16*)(ws + (k == 1 ? WS_WGU1 : WS_WGU2)), TT, 2 * DFF, KL1}; pg8::StaticOrder S; S.init(TT, 2 * DFF, G, bx);
            pg8::Epi<1> E{}; E.O = (bf16*)(ws + WS_HID); E.ldc = DFF; E.ssq = ssq + (size_t)(3 * L + (k == 1 ? 0 : 2)) * TT * 16; E.inv_n = 1.0f / DM;
            pg8::gemm_phase<pg8::Epi<1>, pg8::StaticOrder, true, true>(lds, g, S, E);
        } else if ((k == 2 || k == 8 || k == 10) && EN(2)) {
            pg8::Gemm g{(const bf16*)(ws + (k == 8 ? WS_MB : WS_HID)), (const bf16*)(ws + (k == 2 ? WS_WD1 : (k == 8 ? WS_WOUT : WS_WD2))), TT, DM, k == 8 ? KL1 : KL5};
            pg8::StaticOrder S; S.init(TT, DM, G, bx);
            pg8::Epi<2> E{}; E.O = (ph == N_PHASES - 2) ? nullptr : HB; E.ldc = DM; E.base = (ph == 2) ? ap->in[0] : hbuf; E.outf = hbuf; E.alpha = __uint_as_float((unsigned)__builtin_amdgcn_readfirstlane(k == 8 ? 0x3f800000 : 0x3f000000));
            E.ssq_out = ssq + (size_t)(3 * L + (k == 2 ? 1 : (k == 8 ? 2 : 3))) * TT * 16;
            pg8::gemm_phase<pg8::Epi<2>, pg8::StaticOrder, true, true>(lds, g, S, E);
        } else if (k == 3 && EN(3)) {
            pg8::Gemm g{HB, (const bf16*)(ws + WS_WIN), TT, 2560, KL1}; pg8::StaticOrder S; S.init(TT, 2560, G, bx);
            pg8::Epi<0> E{}; E.O = (bf16*)(ws + WS_Z1); E.ldc = 1024; E.O2 = (bf16*)(ws + WS_Z2); E.ldc2 = 1024; E.split = 1024; E.G = (const bf16*)(ws + WS_VTD); E.ssq = ssq + (size_t)(3 * L + 1) * TT * 16; E.inv_n = 1.0f / DM;
            pg8::gemm_phase<pg8::Epi<0>, pg8::StaticOrder, true, true>(lds, g, S, E);
        } else if (k == 5 && EN(5)) {
            { pg8::Gemm g{(const bf16*)(ws + WS_CQN), (const bf16*)(ws + WS_WUQ), TT, 768, KL3}; pg8::StaticOrder S; S.init(TT, 768, G, bx);
              pg8::Epi<6> E{}; E.O = (bf16*)(ws + WS_QM); E.ldc = 768; pg8::gemm_phase<pg8::Epi<6>, pg8::StaticOrder, true, true>(lds, g, S, E); }
            __syncthreads();
            { pg8::Gemm g{(const bf16*)(ws + WS_CKVN), (const bf16*)(ws + WS_WUKV), TT, 1024, KL4}; pg8::StaticOrder S; S.init(TT, 1024, G, bx);
              pg8::Epi<7> E{}; E.O = (bf16*)(ws + WS_KN); E.ldc = 512; E.O2 = (bf16*)(ws + WS_VTM); pg8::gemm_phase<pg8::Epi<7>, pg8::StaticOrder, true, true>(lds, g, S, E); }
            __syncthreads();
            { pg8::Gemm g{(const bf16*)(ws + WS_POOLED), (const bf16*)(ws + WS_WPOOL), TT, 512, KL2}; pg8::StaticOrder S; S.init(TT, 512, G, bx);
              pg8::Epi<3> E{}; E.O = (bf16*)(ws + WS_YPOOL); E.ldc = 512; E.bias = ap->in[18] + L * 512; E.scale = ap->in[19] + L * 512;
              pg8::gemm_phase<pg8::Epi<3>, pg8::StaticOrder, true, true>(lds, g, S, E); }
        } else if (k == 4 && EN(4)) {
            const bf16* Z1 = (const bf16*)(ws + WS_Z1); bf16* CQN = (bf16*)(ws + WS_CQN); bf16* CKVN = (bf16*)(ws + WS_CKVN); bf16* KR = (bf16*)(ws + WS_KR); bf16* PO = (bf16*)(ws + WS_POOLED);
            const float* q_norm = ap->in[8] + (size_t)L * 256; const float* kv_norm = ap->in[10] + (size_t)L * 128; const int* pos = (const int*)ap->in[1];
            float kmx0 = 0.f, kmx1 = 0.f;
            for (int t = gw; t < TT; t += NGW) {
                const bf16* zr = Z1 + (size_t)t * 1024;
                { const u32x4 kv = *(const u32x4*)((const bf16*)(ws + WS_Z2) + (size_t)t * 1024 + 512 + 8 * lane); float ss = 0.f;
#pragma unroll
                  for (int e = 0; e < 4; ++e) { const float x = bf_lo(kv[e]), y = bf_hi(kv[e]); ss += x * x + y * y; }
                  ss += __shfl_xor(ss, 1); ss += __shfl_xor(ss, 2);
                  if (t < SEQ) kmx0 = fmaxf(kmx0, ss); else kmx1 = fmaxf(kmx1, ss); }
                { const u32x2 v = ((const u32x2*)zr)[lane]; float x0 = bf_lo(v.x), x1 = bf_hi(v.x), x2 = bf_lo(v.y), x3 = bf_hi(v.y);
                  const float rs = __builtin_amdgcn_rsqf(wave_sum(x0 * x0 + x1 * x1 + x2 * x2 + x3 * x3) * (1.0f / 256.0f) + 1e-6f); const f32x4 gq = ((const f32x4*)q_norm)[lane];
                  u32x2 o; o.x = cvt_pk_bf16(x0 * rs * gq.x, x1 * rs * gq.y); o.y = cvt_pk_bf16(x2 * rs * gq.z, x3 * rs * gq.w); ((u32x2*)(CQN + (size_t)t * 256))[lane] = o; }
                { const unsigned v = ((const unsigned*)(zr + 256))[lane]; float x0 = bf_lo(v), x1 = bf_hi(v);
                  const float rs = __builtin_amdgcn_rsqf(wave_sum(x0 * x0 + x1 * x1) * (1.0f / 128.0f) + 1e-6f);
                  ((unsigned*)(CKVN + (size_t)t * 128))[lane] = cvt_pk_bf16(x0 * rs * kv_norm[2 * lane], x1 * rs * kv_norm[2 * lane + 1]); }
                if (lane < 16) { const float x1 = bf_lo((unsigned)zr[384 + lane]), x2 = bf_lo((unsigned)zr[400 + lane]); float s, c; sincos_acc((float)pos[t] * ((const float*)(ws + WS_TAB))[lane], s, c);
                  KR[(size_t)t * 32 + lane] = (bf16)(cvt_pk_bf16(x1 * c - x2 * s, 0.f) & 0xffffu); KR[(size_t)t * 32 + 16 + lane] = (bf16)(cvt_pk_bf16(x2 * c + x1 * s, 0.f) & 0xffffu); }
                { const int tp = t & (SEQ - 1), wdw = 2 << (lane >> 4), cnt = (tp + 1) < wdw ? (tp + 1) : wdw;
                  float a[8]; const u32x4 cur = *(const u32x4*)(zr + 512 + 8 * lane);
#pragma unroll
                  for (int e = 0; e < 4; ++e) { a[2 * e] = bf_lo(cur[e]); a[2 * e + 1] = bf_hi(cur[e]); }
                  float sm[8];
#pragma unroll
                  for (int e = 0; e < 8; ++e) sm[e] = a[e];
                  for (int j = 1; j < cnt; ++j) { const u32x4 pv = *(const u32x4*)(zr - (size_t)j * 1024 + 512 + 8 * lane);
#pragma unroll
                      for (int e = 0; e < 4; ++e) { sm[2 * e] += bf_lo(pv[e]); sm[2 * e + 1] += bf_hi(pv[e]); } }
                  const float ic = 1.0f / (float)cnt; u32x4 o;
#pragma unroll
                  for (int e = 0; e < 4; ++e) o[e] = cvt_pk_bf16(sm[2 * e] * ic - a[2 * e], sm[2 * e + 1] * ic - a[2 * e + 1]);
                  *(u32x4*)(PO + (size_t)t * 512 + 8 * lane) = o; }
            }
            {
                LAS float* red = (LAS float*)lds;
                if ((lane & 3) == 0) { red[(wave * 2 + 0) * 16 + (lane >> 2)] = kmx0; red[(wave * 2 + 1) * 16 + (lane >> 2)] = kmx1; }
                __syncthreads();
                if (tid < 32 && bx < 1024) { float mx = 0.f;
#pragma unroll
                    for (int wv = 0; wv < 8; ++wv) mx = fmaxf(mx, red[(wv * 2 + (tid >> 4)) * 16 + (tid & 15)]);
                    ((float*)(ws + WS_KMAX))[((size_t)L * 1024 + bx) * 32 + tid] = mx; }
                __syncthreads();
            }
        } else if (k == 6 && EN(6)) {
            const int* pos = (const int*)ap->in[1];
            float lam_u;
            { float a1 = lane < 32 ? ap->in[12][L * 32 + lane] * ap->in[13][L * 32 + lane] : 0.f, a2 = lane < 32 ? ap->in[14][L * 32 + lane] * ap->in[15][L * 32 + lane] : 0.f;
              a1 = wave_sum(a1); a2 = wave_sum(a2); const float lv = __expf(a1) - __expf(a2) + (L == 0 ? ap->lam_init[0] : ap->lam_init[1]);
              lam_u = __uint_as_float((unsigned)__builtin_amdgcn_readfirstlane((int)__float_as_uint(lv))); }
            const bool pos_generic = __builtin_amdgcn_readfirstlane((int)__hip_atomic_load((const unsigned*)(ws + WS_POSFLAG), __ATOMIC_RELAXED, __HIP_MEMORY_SCOPE_AGENT)) != 0 || G > 1024;
            {
                volatile LAS unsigned* qslot = (volatile LAS unsigned*)(lds + LDS_MISC + 64);
                unsigned* head = (unsigned*)(ws + WS_ATTQ + 64 * L);
                for (;;) {
                    if (tid == 0) *qslot = __hip_atomic_fetch_add(head, 1u, __ATOMIC_RELAXED, __HIP_MEMORY_SCOPE_AGENT);
                    __syncthreads();
                    const int idx = __builtin_amdgcn_readfirstlane((int)*qslot);
                    __syncthreads();
                    if (idx >= 1024) break;
                    const int code = ap->order[idx], type = code >> 9, b = (code >> 8) & 1, h = (code >> 5) & 7, qb = code & 31;
                    if (type == 0) {
#ifndef NO_ATT0
                        att::P A{}; A.Q = (const bf16*)(ws + WS_QM); A.qpitch = 768; A.K = (const bf16*)(ws + WS_KN) + h * 64; A.kpitch = 512; A.KR = (const bf16*)(ws + WS_KR);
                        A.V = (const bf16*)(ws + WS_VTM); A.vpitch = 0; A.O = (bf16*)(ws + WS_OM); A.pos = pos; A.invf = (const float*)(ws + WS_TAB);
                        att::attn_unit<0>(lds, A, b, h, qb);
#endif
                    } else {
#ifndef NO_ATT1
                        att::P A{}; A.Q = (const bf16*)(ws + WS_Z2); A.qpitch = 1024; A.K = (const bf16*)(ws + WS_Z2) + 512 + h * 64; A.kpitch = 1024; A.V = (const bf16*)(ws + WS_VTD); A.vpitch = 0;
                        A.O = (bf16*)(ws + WS_OD); A.pos = pos; A.subln = ap->in[16] + L * 64; A.lam = lam_u; A.kmax = (const float*)(ws + WS_KMAX) + (size_t)L * 1024 * 32; A.nblk = G;
                        A.lam_init = L == 0 ? ap->lam_init[0] : ap->lam_init[1];
                        if (pos_generic) att::attn_unit<1, false>(lds, A, b, h, qb); else att::attn_unit<1, true>(lds, A, b, h, qb);
#endif
                    }
                }
            }
        } else if (k == 7 && EN(7)) {
#pragma nounroll
            for (int i = 0; i < 3; ++i) {
                { pg8::Gemm g{HB, (const bf16*)(ws + WS_WG) + (size_t)i * 1024 * 1024, TT, 1024, KL1}; pg8::StaticOrder S; S.init(TT, 1024, G, bx);
                  pg8::Epi<4> E{}; E.O = (bf16*)(ws + WS_GT); E.ldc = 1024; E.ssq = ssq + (size_t)(3 * L + 1) * TT * 16; E.inv_n = 1.0f / DM; pg8::gemm_phase<pg8::Epi<4>, pg8::StaticOrder, true, true>(lds, g, S, E); }
                __syncthreads();
                { const bf16* Oi = (const bf16*)(ws + (i == 0 ? WS_OM : (i == 1 ? WS_OD : WS_YPOOL)));
                  pg8::Gemm g{Oi, (const bf16*)(ws + WS_WB) + (size_t)i * 1024 * 512, TT, 1024, KL2}; pg8::StaticOrder S; S.init(TT, 1024, G, bx);
                  pg8::Epi<5> E{}; E.O = (bf16*)(ws + WS_MB); E.ldc = 1024; E.G = (const bf16*)(ws + WS_GT); E.first = (i == 0); pg8::gemm_phase<pg8::Epi<5>, pg8::StaticOrder, true, true>(lds, g, S, E); }
                __syncthreads();
            }
        }
        if (multi && ph + 1 < hi_ph) { if (lo == 0x7fffff01) cg::this_grid().sync();   else xcd_barrier(bar); }
    }
}

#ifndef MK_PER_PHASE
#define MK_PER_PHASE 0
#endif
extern "C" void kernel_launch(void* const* d_in, const int* in_sizes, int n_in, void* d_out, int out_size, void* d_ws, size_t ws_size, hipStream_t stream) {
    static int grid = 0;
    if (grid == 0) {
        if (n_in != 27 || out_size != TT * DM || ws_size < WS_END) { fprintf(stderr, "kernel_launch: unexpected shapes (n_in %d out %d ws %zu)\n", n_in, out_size, ws_size); grid = -1; return; }
        int dev = 0, cus = 0, per_cu = 0;
        (void)hipGetDevice(&dev); (void)hipDeviceGetAttribute(&cus, hipDeviceAttributeMultiprocessorCount, dev);
        if (hipFuncSetAttribute((const void*)fwd_kernel, hipFuncAttributeMaxDynamicSharedMemorySize, LDS_BYTES) != hipSuccess) { fprintf(stderr, "kernel_launch: hipFuncSetAttribute failed\n"); grid = -1; return; }
        if (hipOccupancyMaxActiveBlocksPerMultiprocessor(&per_cu, (const void*)fwd_kernel, NTHR, LDS_BYTES) != hipSuccess || per_cu < 1) { fprintf(stderr, "kernel_launch: occupancy query says %d\n", per_cu); per_cu = 1; }
        (void)hipGetLastError();
        grid = cus * 1;
        fprintf(stderr, "kernel_launch: grid %d (cus %d, per_cu %d)\n", grid, cus, per_cu);
    }
    if (grid < 0) return;
    (void)hipMemsetAsync((char*)d_ws + WS_BAR, 0, BAR_ZERO_BYTES, stream);
    Args a{};
    for (int i = 0; i < 27; ++i) a.in[i] = (const float*)d_in[i];
    a.out = (float*)d_out; a.ws = (unsigned char*)d_ws;
    for (int i = 0; i < 16; ++i) a.invf[i] = (float)pow(10000.0, -(double)i / 16.0);
    for (int l = 0; l < 2; ++l) a.lam_init[l] = (float)(0.8 - 0.6 * exp(-0.3 * l));
    {
        static const int wcap[8] = {8, 12, 19, 33, 62, 120, 128, 128};
        struct U { float cost; unsigned short code; }; U us[1024]; int n = 0;
        for (int type = 0; type < 2; ++type) for (int b = 0; b < 2; ++b) for (int h = 0; h < 8; ++h) for (int qb = 0; qb < 32; ++qb) {
            const int nt = 4 * (qb + 1); float c;
            if (type == 0) c = 1.95f * nt + 3.0f; else { const int tt = nt < wcap[h] ? nt : wcap[h]; c = 3.1f * tt + 4.0f; }
            us[n].cost = c; us[n].code = (unsigned short)((type << 9) | (b << 8) | (h << 5) | qb); ++n; }
        for (int i = 1; i < 1024; ++i) { const U x = us[i]; int j = i - 1; while (j >= 0 && (us[j].cost < x.cost || (us[j].cost == x.cost && us[j].code > x.code))) { us[j + 1] = us[j]; --j; } us[j + 1] = x; }
        for (int i = 0; i < 1024; ++i) a.order[i] = us[i].code;
    }
#if MK_PER_PHASE
    for (int p = 0; p < N_PHASES; ++p) { a.ph_lo = p; a.ph_hi = p + 1; hipLaunchKernelGGL(fwd_kernel, dim3(grid), dim3(NTHR), LDS_BYTES, stream, a); }
#else
    a.ph_lo = 0; a.ph_hi = N_PHASES;
    void* kargs[] = {&a};
    hipError_t e = hipLaunchCooperativeKernel((const void*)fwd_kernel, dim3(grid), dim3(NTHR), kargs, LDS_BYTES, stream);
    if (e != hipSuccess) fprintf(stderr, "cooperative launch failed: %s (grid %d)\n", hipGetErrorString(e), grid);
#endif
}
```

```cpp
#include <hip/hip_runtime.h>
#include <hip/hip_cooperative_groups.h>
#include <cstdio>
#include <cstdint>
#include <cmath>
namespace cg = cooperative_groups;
namespace pg8 {
#define PG8_LAS __attribute__((address_space(3)))
typedef unsigned short bf16_t;
typedef short bf16x8 __attribute__((ext_vector_type(8)));
typedef float f32x4 __attribute__((ext_vector_type(4)));
typedef unsigned u32x4 __attribute__((ext_vector_type(4)));
constexpr int BM = 256, BK = 64, HALF = 128, HTB = HALF * BK * 2  , STAGE_BYTES = 8 * HTB, NXCD = 8, WGM = 8;

__host__ __device__ __forceinline__ int lds_byte(int r, int c) { const int st = (r >> 4) * 2 + (c >> 5), rr = r & 15, cc = c & 31, ob = rr * 64 + cc * 2; return st * 1024 + (ob ^ (((ob >> 9) & 1) << 5)); }
__host__ __device__ __forceinline__ void stage_rc(int b, int& R, int& C) { const int st = b / 1024, sb = b % 1024, swz = sb ^ (((sb >> 9) & 1) << 5); R = (st >> 1) * 16 + swz / 64; C = (st & 1) * 32 + (swz % 64) / 2; }
__host__ __device__ __forceinline__ int perm32(int rho) { const int n = rho >> 4, i = rho & 15; return 8 * (i >> 2) + 4 * n + (i & 3); }

struct Unit { int pm, pn; };
struct Gemm { const bf16_t* A; const bf16_t* Bt; int M, N, K; };

struct StaticOrder {
    int nM, nN, nwg, G, c;
    __host__ __device__ void init(int M, int N, int G_, int c_) { nM = M / BM; nN = N / BM; nwg = nM * nN; G = G_; c = c_; }
    __host__ __device__ bool next(int i, Unit& u) const {
        const long L = (long)i * G + c; if (L >= nwg) return false;
        int wgid = (int)L; { const int q = nwg / NXCD, r = nwg % NXCD, xcd = wgid % NXCD, off = wgid / NXCD; wgid = (xcd < r ? xcd * (q + 1) : r * (q + 1) + (xcd - r) * q) + off; }
        const int nig = WGM * nN, gid = wgid / nig, fm = gid * WGM, gsz = (nM - fm) < WGM ? (nM - fm) : WGM;
        u.pm = fm + ((wgid % nig) % gsz); u.pn = (wgid % nig) / gsz; return true;
    }
    __device__ __forceinline__ void a_ready(const Unit&) const {}
    __device__ __forceinline__ void done(const Unit&) const {}
};

typedef float f32x2_cv __attribute__((ext_vector_type(2))); typedef __bf16 bf16x2_cv __attribute__((ext_vector_type(2)));
__device__ __forceinline__ unsigned cvt_pk_bf16(float lo, float hi) { f32x2_cv v = {lo, hi}; bf16x2_cv b = __builtin_convertvector(v, bf16x2_cv); return __builtin_bit_cast(unsigned, b); }
typedef float f32x2 __attribute__((ext_vector_type(2)));
typedef unsigned u32x2 __attribute__((ext_vector_type(2)));
constexpr float RMS_EPS = 1e-6f;
__device__ __forceinline__ float sigmoid_f(float x) { return __builtin_amdgcn_rcpf(1.f + __builtin_amdgcn_exp2f(-1.4426950408889634f * x)); }
__device__ __forceinline__ float row_ssq(const float* ssq, int r) { const f32x4* p = (const f32x4*)(ssq + (unsigned)(r * 16)); const f32x4 a = p[0], b = p[1], c = p[2], d = p[3];
    return ((a[0] + a[1]) + (a[2] + a[3])) + ((b[0] + b[1]) + (b[2] + b[3])) + ((c[0] + c[1]) + (c[2] + c[3])) + ((d[0] + d[1]) + (d[2] + d[3])); }
__device__ __forceinline__ float bf_lo(unsigned u) { return __uint_as_float(u << 16); }
__device__ __forceinline__ float bf_hi(unsigned u) { return __uint_as_float(u & 0xffff0000u); }
__device__ __forceinline__ u32x4 pack8(const f32x4 v0, const f32x4 v1) { u32x4 w; w.x = cvt_pk_bf16(v0[0], v0[1]); w.y = cvt_pk_bf16(v0[2], v0[3]); w.z = cvt_pk_bf16(v1[0], v1[1]); w.w = cvt_pk_bf16(v1[2], v1[3]); return w; }
template <int MODE> struct Epi {
    static constexpr bool PERM = true, AFTER_DRAIN = false;
    bf16_t* O; int ldc; bf16_t* O2; int ldc2; int split;
    const float* ssq; float inv_n;
    const float* base; float* outf; float alpha; float* ssq_out;
    const float* bias; const float* scale;
    const bf16_t* G; int first;
    __device__ __forceinline__ void operator()(const f32x4 (&acc)[2][2][4][2], const Unit& u, int wr, int wc, int fr, int fq) const {
        bf16_t* O = this->O; bf16_t* O2 = this->O2; const float* ssq = this->ssq; const float* base = this->base; float* outf = this->outf; float* ssq_out = this->ssq_out;
        const float* bias = this->bias; const float* scale = this->scale; const bf16_t* G = this->G; unsigned alpha_u = __float_as_uint(this->alpha), inv_u = __float_as_uint(this->inv_n);
        asm volatile("" : "+s"(O), "+s"(O2), "+s"(ssq), "+s"(base), "+s"(outf), "+s"(ssq_out));
        asm volatile("" : "+s"(bias), "+s"(scale), "+s"(G), "+s"(alpha_u), "+s"(inv_u));
        const float alpha = __uint_as_float(alpha_u), inv_n = __uint_as_float(inv_u);
        { int t_ = threadIdx.x; asm volatile("" : "+v"(t_)); fr = t_ & 15; fq = (t_ >> 4) & 3; }
        const int row0 = u.pm * BM + wr * 64 + fr;
        if constexpr (MODE == 1) {
            const int col0 = u.pn * HALF + wc * 32 + 8 * fq;
#pragma unroll
            for (int ai = 0; ai < 2; ++ai)
#pragma unroll
                for (int m = 0; m < 4; ++m) { const int r = row0 + ai * HALF + m * 16; const float sc = __builtin_amdgcn_rsqf(row_ssq(ssq, r) * inv_n + RMS_EPS);
                    f32x4 o[2];
#pragma unroll
                    for (int n = 0; n < 2; ++n)
#pragma unroll
                        for (int e = 0; e < 4; ++e) { const float g = acc[ai][0][m][n][e] * sc, uu = acc[ai][1][m][n][e] * sc; o[n][e] = g * sigmoid_f(g) * uu; }
                    *(u32x4*)(O + (unsigned)(r * ldc + col0)) = pack8(o[0], o[1]); }
        } else if constexpr (MODE == 2) {
#pragma unroll
            for (int ai = 0; ai < 2; ++ai)
#pragma unroll
                for (int m = 0; m < 4; ++m) { const int r = row0 + ai * HALF + m * 16; float s = 0.f;
#pragma unroll
                    for (int bj = 0; bj < 2; ++bj) { const unsigned off = (unsigned)(r * 1024 + u.pn * BM + bj * HALF + wc * 32 + 8 * fq);
                        const u32x4 bq = *(const u32x4*)(O + off);
                        const f32x4 b0 = {bf_lo(bq.x), bf_hi(bq.x), bf_lo(bq.y), bf_hi(bq.y)}, b1 = {bf_lo(bq.z), bf_hi(bq.z), bf_lo(bq.w), bf_hi(bq.w)};
                        const f32x4 h0 = b0 + acc[ai][bj][m][0] * alpha, h1 = b1 + acc[ai][bj][m][1] * alpha;
                        *(u32x4*)(O + off) = pack8(h0, h1);
                        s += (h0[0] * h0[0] + h0[1] * h0[1]) + (h0[2] * h0[2] + h0[3] * h0[3]) + (h1[0] * h1[0] + h1[1] * h1[1]) + (h1[2] * h1[2] + h1[3] * h1[3]); }
                    s += __shfl_xor(s, 16); s += __shfl_xor(s, 32);
                    if (fq == 0) ssq_out[(unsigned)(r * 16 + u.pn * 4 + wc)] = s;
                    asm volatile("" ::: "memory"); }
        } else if constexpr (MODE == 7) {
#pragma unroll
            for (int ai = 0; ai < 2; ++ai)
#pragma unroll
                for (int m = 0; m < 4; ++m) { const int r = row0 + ai * HALF + m * 16;
#pragma unroll
                    for (int bj = 0; bj < 2; ++bj) { const int hh = 2 * u.pn + bj; const f32x4 v0 = acc[ai][bj][m][0], v1 = acc[ai][bj][m][1];
                        if (wc < 2) *(u32x4*)(O + (unsigned)(r * 512 + hh * 64 + wc * 32 + 8 * fq)) = pack8(v0, v1);
                        else { bf16_t* vt = O2 + (unsigned)((((r >> 13) * 8 + hh) * 64 + (wc - 2) * 32 + 8 * fq) * 8192 + (r & 8191));
#pragma unroll
                            for (int e = 0; e < 4; ++e) { vt[(unsigned)(e * 8192)] = (bf16_t)(cvt_pk_bf16(v0[e], 0.f) & 0xffffu); vt[(unsigned)((4 + e) * 8192)] = (bf16_t)(cvt_pk_bf16(v1[e], 0.f) & 0xffffu); } } } }
        } else {
            int colt = u.pn * BM; bf16_t* ob = O; int ld = ldc;
            if (MODE == 0 && colt >= split) { ob = O2; ld = ldc2; colt -= split; }
            if (MODE == 0 && colt >= 1024) {
                bf16_t* VT = (bf16_t*)G;
#pragma unroll
                for (int ai = 0; ai < 2; ++ai)
#pragma unroll
                    for (int m = 0; m < 4; ++m) { const int r = row0 + ai * HALF + m * 16; const float sc = __builtin_amdgcn_rsqf(row_ssq(ssq, r) * inv_n + RMS_EPS);
#pragma unroll
                        for (int bj = 0; bj < 2; ++bj) { const f32x4 v0 = acc[ai][bj][m][0] * sc, v1 = acc[ai][bj][m][1] * sc;
                            bf16_t* vt = VT + (unsigned)(((r >> 13) * 512 + (colt - 1024) + bj * HALF + wc * 32 + 8 * fq) * 8192 + (r & 8191));
#pragma unroll
                            for (int e = 0; e < 4; ++e) { vt[(unsigned)(e * 8192)] = (bf16_t)(cvt_pk_bf16(v0[e], 0.f) & 0xffffu); vt[(unsigned)((4 + e) * 8192)] = (bf16_t)(cvt_pk_bf16(v1[e], 0.f) & 0xffffu); } } }
                return;
            }
            const int col0 = colt + wc * 32 + 8 * fq, gcol0 = u.pn * BM + wc * 32 + 8 * fq;
            f32x4 bv[2][2], sv[2][2];
            if constexpr (MODE == 3) {
#pragma unroll
                for (int bj = 0; bj < 2; ++bj)
#pragma unroll
                    for (int n = 0; n < 2; ++n) { bv[bj][n] = *(const f32x4*)(bias + gcol0 + bj * HALF + 4 * n); sv[bj][n] = *(const f32x4*)(scale + gcol0 + bj * HALF + 4 * n); }
            }
#pragma unroll
            for (int ai = 0; ai < 2; ++ai)
#pragma unroll
                for (int m = 0; m < 4; ++m) { const int r = row0 + ai * HALF + m * 16;
                    float sc = 1.f; if (MODE == 0 || MODE == 4) sc = __builtin_amdgcn_rsqf(row_ssq(ssq, r) * inv_n + RMS_EPS);
#pragma unroll
                    for (int bj = 0; bj < 2; ++bj) { f32x4 v0 = acc[ai][bj][m][0], v1 = acc[ai][bj][m][1]; bf16_t* p = ob + (unsigned)(r * ld + col0 + bj * HALF);
                        if constexpr (MODE == 0) { v0 = v0 * sc; v1 = v1 * sc; }
                        if constexpr (MODE == 3) { v0 = (v0 + bv[bj][0]) * sv[bj][0]; v1 = (v1 + bv[bj][1]) * sv[bj][1]; }
                        if constexpr (MODE == 4) {
#pragma unroll
                            for (int e = 0; e < 4; ++e) { v0[e] = sigmoid_f(v0[e] * sc); v1[e] = sigmoid_f(v1[e] * sc); } }
                        if constexpr (MODE == 5) { const u32x4 g = *(const u32x4*)(G + (unsigned)(r * ld + col0 + bj * HALF));
                            v0 = v0 * (f32x4){bf_lo(g.x), bf_hi(g.x), bf_lo(g.y), bf_hi(g.y)}; v1 = v1 * (f32x4){bf_lo(g.z), bf_hi(g.z), bf_lo(g.w), bf_hi(g.w)};
                            if (!first) { const u32x4 q = *(const u32x4*)p; v0 = v0 + (f32x4){bf_lo(q.x), bf_hi(q.x), bf_lo(q.y), bf_hi(q.y)}; v1 = v1 + (f32x4){bf_lo(q.z), bf_hi(q.z), bf_lo(q.w), bf_hi(q.w)}; } }
                        *(u32x4*)p = pack8(v0, v1); }
                    if (MODE == 5 || MODE == 4) asm volatile("" ::: "memory"); }
        }
    }
};
template <class Epi, class Sched, bool ALIGN_EPI = false, bool SP2 = false>
__device__ __forceinline__ void gemm_phase(PG8_LAS unsigned char* lds, const Gemm g, const Sched& S, const Epi& E) {
    int tid_l = threadIdx.x; asm volatile("" : "+v"(tid_l));
    const int tid = tid_l, wid = __builtin_amdgcn_readfirstlane(tid >> 6), lane = tid & 63, wr = wid >> 2, wc = wid & 3, fr = lane & 15, fq = lane >> 4;
    const int K = g.K, nt = K / BK;
    unsigned voffA[2], voffB[2];
#pragma unroll
    for (int i = 0; i < 2; ++i) { int R, C; stage_rc(tid * 16 + i * 8192, R, C); const int Rb = Epi::PERM ? ((R & ~31) + perm32(R & 31)) : R;
        voffA[i] = (unsigned)(R * K + C) * 2u; voffB[i] = (unsigned)(Rb * K + C) * 2u; }
    const size_t kstep = (size_t)(BK * 2);
    const size_t hstep = (size_t)HALF * K * 2;
    const size_t tstep = 2 * hstep;
    const unsigned ldsw = (unsigned)wid * 1024u;
    const int aoff = lds_byte(wr * 64 + fr, fq * 8), boff = lds_byte(wc * 32 + fr, fq * 8);
#define PG8_SA(b, h) (((b) * 2 + (h)) * HTB)
#define PG8_SB(b, h) ((4 + (b) * 2 + (h)) * HTB)
#define PG8_STAGE(bufoff, gbase, voff) do { _Pragma("unroll") for (int _i = 0; _i < 2; ++_i) \
        __builtin_amdgcn_global_load_lds((const unsigned*)((const char*)(gbase) + (voff)[_i]), (PG8_LAS unsigned*)(lds + (bufoff) + ldsw + _i * 8192), 16, 0, 0); } while (0)
#define PG8_LDA(dst, b, h) do { _Pragma("unroll") for (int m = 0; m < 4; ++m) _Pragma("unroll") for (int k = 0; k < 2; ++k) dst[m][k] = *(const PG8_LAS bf16x8*)(lds + PG8_SA(b, h) + aoff + m * 2048 + k * 1024); } while (0)
#define PG8_LDB(dst, b, h) do { _Pragma("unroll") for (int n = 0; n < 2; ++n) _Pragma("unroll") for (int k = 0; k < 2; ++k) dst[n][k] = *(const PG8_LAS bf16x8*)(lds + PG8_SB(b, h) + boff + n * 2048 + k * 1024); } while (0)
#define PG8_MMA(ai, bj, At, Bt) do { __builtin_amdgcn_s_setprio(1); _Pragma("unroll") for (int m = 0; m < 4; ++m) _Pragma("unroll") for (int n = 0; n < 2; ++n) _Pragma("unroll") for (int k = 0; k < 2; ++k) \
        acc[ai][bj][m][n] = __builtin_amdgcn_mfma_f32_16x16x32_bf16(Bt[n][k], At[m][k], acc[ai][bj][m][n], 0, 0, 0); __builtin_amdgcn_s_setprio(0); } while (0)
#define PG8_WAIT_V(n) asm volatile("s_waitcnt vmcnt(" #n ")" ::: "memory")
#define PG8_WAIT_L(n) asm volatile("s_waitcnt lgkmcnt(" #n ")" ::: "memory")
#define PG8_BAR __builtin_amdgcn_s_barrier()
#define PG8_SCHED __builtin_amdgcn_sched_barrier(0)
    Unit cur, nxt; int ui = 0;
    if (!S.next(0, cur)) return;
    f32x4 acc[2][2][4][2];
#pragma unroll
    for (int a = 0; a < 2; ++a)
#pragma unroll
        for (int b = 0; b < 2; ++b)
#pragma unroll
            for (int m = 0; m < 4; ++m)
#pragma unroll
                for (int n = 0; n < 2; ++n) acc[a][b][m][n] = (f32x4){0.f, 0.f, 0.f, 0.f};
    bf16x8 At[4][2], B0[2][2], B1[2][2];
    const char* cA = (const char*)g.A + (size_t)cur.pm * tstep; const char* cB = (const char*)g.Bt + (size_t)cur.pn * tstep;
    S.a_ready(cur);
    if constexpr (SP2) {
        PG8_STAGE(PG8_SB(0, 0), cB, voffB); PG8_STAGE(PG8_SB(0, 1), cB + hstep, voffB); PG8_STAGE(PG8_SA(0, 0), cA, voffA); PG8_STAGE(PG8_SA(0, 1), cA + hstep, voffA);
        if (wr == 1) PG8_BAR;
        PG8_WAIT_V(2); PG8_BAR;
        PG8_STAGE(PG8_SB(1, 0), cB + kstep, voffB); PG8_STAGE(PG8_SA(1, 0), cA + kstep, voffA); PG8_STAGE(PG8_SB(1, 1), cB + hstep + kstep, voffB);
        PG8_WAIT_V(6); PG8_BAR;
    } else {
        PG8_STAGE(PG8_SB(0, 0), cB, voffB); PG8_STAGE(PG8_SA(0, 0), cA, voffA); PG8_STAGE(PG8_SB(0, 1), cB + hstep, voffB); PG8_STAGE(PG8_SA(0, 1), cA + hstep, voffA);
        if (wr == 1) PG8_BAR;
        PG8_WAIT_V(4); PG8_BAR;
        PG8_STAGE(PG8_SB(1, 0), cB + kstep, voffB); PG8_STAGE(PG8_SA(1, 0), cA + kstep, voffA); PG8_STAGE(PG8_SB(1, 1), cB + hstep + kstep, voffB);
        PG8_WAIT_V(6); PG8_BAR;
    }
    for (;;) {
        const bool has_next = S.next(ui + 1, nxt);
        const char* nA = has_next ? (const char*)g.A + (size_t)nxt.pm * tstep : cA; const char* nB = has_next ? (const char*)g.Bt + (size_t)nxt.pn * tstep : cB;
        for (int t = 0; t < nt; t += 2) {
            const bool last = (t == nt - 2);
            const char* a1 = cA + (size_t)(t + 1) * kstep;
            const char* a2 = last ? nA : cA + (size_t)(t + 2) * kstep; const char* b2 = last ? nB : cB + (size_t)(t + 2) * kstep;
            const char* a3 = a2 + kstep; const char* b3 = b2 + kstep;
            if (last && has_next) S.a_ready(nxt);
            if constexpr (SP2) {
            PG8_LDB(B0, 0, 0); PG8_LDB(B1, 0, 1); PG8_SCHED; PG8_LDA(At, 0, 0); PG8_STAGE(PG8_SA(1, 1), a1 + hstep, voffA);
            PG8_WAIT_V(8); PG8_WAIT_L(0); PG8_BAR; PG8_MMA(0, 0, At, B0); PG8_MMA(0, 1, At, B1); PG8_BAR; PG8_SCHED;
            PG8_LDA(At, 0, 1); PG8_STAGE(PG8_SB(0, 0), b2, voffB); PG8_STAGE(PG8_SB(0, 1), b2 + hstep, voffB); PG8_STAGE(PG8_SA(0, 0), a2, voffA);
            PG8_WAIT_V(8); PG8_WAIT_L(0); PG8_BAR; PG8_MMA(1, 0, At, B0); PG8_MMA(1, 1, At, B1); PG8_BAR; PG8_SCHED;
            PG8_LDB(B0, 1, 0); PG8_LDB(B1, 1, 1); PG8_SCHED; PG8_LDA(At, 1, 0); PG8_STAGE(PG8_SA(0, 1), a2 + hstep, voffA);
            PG8_WAIT_V(8); PG8_WAIT_L(0); PG8_BAR; PG8_MMA(0, 0, At, B0); PG8_MMA(0, 1, At, B1); PG8_BAR; PG8_SCHED;
            PG8_LDA(At, 1, 1); PG8_STAGE(PG8_SB(1, 0), b3, voffB); PG8_STAGE(PG8_SB(1, 1), b3 + hstep, voffB); PG8_STAGE(PG8_SA(1, 0), a3, voffA);
            PG8_WAIT_V(8); PG8_WAIT_L(0); PG8_BAR; PG8_MMA(1, 0, At, B0); PG8_MMA(1, 1, At, B1); PG8_BAR; PG8_SCHED;
            } else {
            PG8_LDB(B0, 0, 0); PG8_SCHED; PG8_LDA(At, 0, 0); PG8_STAGE(PG8_SA(1, 1), a1 + hstep, voffA);
            PG8_WAIT_L(8); PG8_BAR; PG8_WAIT_L(0); PG8_MMA(0, 0, At, B0); PG8_BAR; PG8_SCHED;
            PG8_LDB(B1, 0, 1); PG8_STAGE(PG8_SB(0, 0), b2, voffB);
            PG8_BAR; PG8_WAIT_L(0); PG8_MMA(0, 1, At, B1); PG8_BAR;
            PG8_LDA(At, 0, 1); PG8_STAGE(PG8_SA(0, 0), a2, voffA);
            PG8_BAR; PG8_WAIT_L(0); PG8_MMA(1, 0, At, B0); PG8_BAR; PG8_SCHED;
            PG8_STAGE(PG8_SB(0, 1), b2 + hstep, voffB);
            PG8_WAIT_V(6); PG8_BAR; PG8_MMA(1, 1, At, B1); PG8_BAR;
            PG8_LDB(B0, 1, 0); PG8_SCHED; PG8_LDA(At, 1, 0); PG8_STAGE(PG8_SA(0, 1), a2 + hstep, voffA);
            PG8_WAIT_L(8); PG8_BAR; PG8_WAIT_L(0); PG8_MMA(0, 0, At, B0); PG8_BAR; PG8_SCHED;
            PG8_LDB(B1, 1, 1); PG8_STAGE(PG8_SB(1, 0), b3, voffB);
            PG8_BAR; PG8_WAIT_L(0); PG8_MMA(0, 1, At, B1); PG8_BAR;
            PG8_LDA(At, 1, 1); PG8_STAGE(PG8_SA(1, 0), a3, voffA);
            PG8_BAR; PG8_WAIT_L(0); PG8_MMA(1, 0, At, B0); PG8_BAR; PG8_SCHED;
            PG8_STAGE(PG8_SB(1, 1), b3 + hstep, voffB);
            PG8_WAIT_V(6); PG8_BAR; PG8_MMA(1, 1, At, B1); PG8_BAR;
            }
        }
        if constexpr (ALIGN_EPI) { if (wr == 0) PG8_BAR; }
        if constexpr (!Epi::AFTER_DRAIN) { E(acc, cur, wr, wc, fr, fq); S.done(cur); }
        if (!has_next) break;
#pragma unroll
        for (int a = 0; a < 2; ++a)
#pragma unroll
            for (int b = 0; b < 2; ++b)
#pragma unroll
                for (int m = 0; m < 4; ++m)
#pragma unroll
                    for (int n = 0; n < 2; ++n) acc[a][b][m][n] = (f32x4){0.f, 0.f, 0.f, 0.f};
        cur = nxt; cA = nA; cB = nB; ++ui;
        if constexpr (ALIGN_EPI) { if (wr == 1) PG8_BAR; }
    }
    PG8_WAIT_V(0);
    if constexpr (!ALIGN_EPI) { if (wr == 0) PG8_BAR; }
    PG8_BAR;
    if constexpr (Epi::AFTER_DRAIN) { E.fused(acc, cur, wr, wc, fr, fq, lds, wid, lane); S.done(cur); }
#undef PG8_SA
#undef PG8_SB
#undef PG8_STAGE
#undef PG8_LDA
#undef PG8_LDB
#undef PG8_MMA
#undef PG8_WAIT_V
#undef PG8_WAIT_L
#undef PG8_BAR
#undef PG8_SCHED
}
}
constexpr int NB = 2, SEQ = 8192, DM = 1024, TT = NB * SEQ, DFF = 2816, NLAYER = 2;
constexpr int NWAVES = 8, NTHR = 512;
typedef unsigned short bf16;
typedef float f32x4 __attribute__((ext_vector_type(4)));
typedef float f32x16 __attribute__((ext_vector_type(16)));
typedef short bf16x8 __attribute__((ext_vector_type(8)));
typedef unsigned u32x4 __attribute__((ext_vector_type(4)));
typedef unsigned u32x2 __attribute__((ext_vector_type(2)));
#define LAS __attribute__((address_space(3)))
#define GAS __attribute__((address_space(1)))
using pg8::cvt_pk_bf16; using pg8::bf_lo; using pg8::bf_hi;

constexpr size_t MiB = 1u << 20;
constexpr size_t WS_SSQ = 249 * MiB;
constexpr size_t WS_WGU1 = 1 * MiB, WS_WD1 = 12 * MiB, WS_WIN = 17 * MiB + 512 * 1024, WS_WG = 22 * MiB + 512 * 1024;
constexpr size_t WS_WUQ = 28 * MiB + 512 * 1024, WS_WUKV = WS_WUQ + 384 * 1024, WS_WPOOL = WS_WUKV + 256 * 1024, WS_WB = WS_WPOOL + 512 * 1024;
constexpr size_t WS_WOUT = WS_WB + 3 * MiB, WS_WGU2 = WS_WOUT + 2 * MiB, WS_WD2 = WS_WGU2 + 11 * MiB;
static_assert(WS_WD2 + (size_t)DM * DFF * 2 <= 52 * MiB, "weights");
constexpr size_t WS_HB = 52 * MiB;
constexpr size_t WS_HID = 84 * MiB;
constexpr size_t WS_Z1 = 84 * MiB, WS_Z2 = 116 * MiB, WS_VTD = 148 * MiB;
constexpr size_t WS_CQN = 164 * MiB, WS_CKVN = 172 * MiB, WS_KR = 176 * MiB, WS_POOLED = 177 * MiB;
constexpr size_t WS_QM = 193 * MiB, WS_KN = 217 * MiB, WS_VTM = 233 * MiB;
constexpr size_t WS_YPOOL = 84 * MiB, WS_OM = 100 * MiB, WS_OD = 177 * MiB;
constexpr size_t WS_GT = 193 * MiB, WS_MB = 116 * MiB;
constexpr size_t WS_ATTQ = 14336;
constexpr size_t WS_KMAX = 51 * MiB + 256 * 1024;
constexpr size_t WS_POSFLAG = 15360;
constexpr size_t WS_TAB = 768 * 1024;
constexpr size_t WS_END = 256 * MiB;

constexpr size_t WS_BAR = 0, BAR_ZERO_BYTES = 16384;
constexpr int LDS_BYTES = 147456, LDS_MISC = 131072 + 1024;

struct Args { const float* in[27]; float* out; unsigned char* ws; float invf[16]; float lam_init[2]; int ph_lo, ph_hi; unsigned short order[1024]; };
static_assert(sizeof(Args) == 29 * 8 + 18 * 4 + 8 + 2048, "Args has no padding");

__device__ __forceinline__ float wave_sum(float v) {
#pragma unroll
    for (int o = 1; o < 64; o <<= 1) v += __shfl_xor(v, o);
    return v;
}
__device__ __forceinline__ void sincos_acc(float ang, float& s, float& c) {
    double rev = (double)ang * 0.15915494309189535; rev -= __builtin_rint(rev); const float fr = (float)rev;
    s = __builtin_amdgcn_sinf(fr); c = __builtin_amdgcn_cosf(fr);
}

__device__ __forceinline__ void transpose_item(const float* W, int N, const float* gain, bf16* WT, int ldt, int k0, int n0, int drow, LAS float* scr, int lane) {
    const int kq = lane >> 3, n4 = (lane & 7) * 4;
#pragma unroll
    for (int i = 0; i < 8; ++i) { const int kk = kq + 8 * i; f32x4 v = *(const f32x4*)(W + (size_t)(k0 + kk) * N + n0 + n4); if (gain) v = v * gain[k0 + kk];
        LAS float* sp = scr + kk * 33 + n4; sp[0] = v.x; sp[1] = v.y; sp[2] = v.z; sp[3] = v.w; }
    asm volatile("s_waitcnt lgkmcnt(0)" ::: "memory");
    const int c = lane & 7;
#pragma unroll
    for (int j = 0; j < 4; ++j) { const int n = (lane >> 3) + 8 * j; const LAS float* s = scr + (8 * c) * 33 + n;
        u32x4 o; o.x = cvt_pk_bf16(s[0 * 33], s[1 * 33]); o.y = cvt_pk_bf16(s[2 * 33], s[3 * 33]); o.z = cvt_pk_bf16(s[4 * 33], s[5 * 33]); o.w = cvt_pk_bf16(s[6 * 33], s[7 * 33]);
        *(u32x4*)(WT + (size_t)(drow + n) * ldt + k0 + 8 * c) = o; }
    asm volatile("s_waitcnt lgkmcnt(0)" ::: "memory");
}
template <int MAP> __device__ __forceinline__ void conv_matrix(const float* W, int K, int N, const float* gain, bf16* WT, int& base, int gw, int NGW, LAS float* scr, int lane) {
    const int nblk = N / 32, nitems = (K / 64) * nblk;
    int first = (gw - base) % NGW; if (first < 0) first += NGW;
    for (int it = first; it < nitems; it += NGW) {
        const int kb = it / nblk, nb = it % nblk, n0 = 32 * nb; int drow = n0;
        if (MAP == 1) drow = (n0 >> 7) * 256 + (n0 & 127);
        if (MAP == 2) drow = (n0 >> 7) * 256 + 128 + (n0 & 127);
        if (MAP == 3) drow = n0 < 416 ? n0 : (n0 < 1952 ? n0 - 416 + 1024 : (n0 < 2464 ? n0 - 1952 + 512 : n0 + 96));
        transpose_item(W, N, gain, WT, K, 64 * kb, n0, drow, scr, lane);
    }
    base = (base + nitems) % NGW;
}

namespace att {
constexpr int VP = 136, VB = 64 * VP;
template <int MODE> struct Cfg { static constexpr int DQK = MODE == 0 ? 96 : 64, NQ = DQK / 16, KP = DQK * 2 + 16, KB = 64 * KP, BUF = KB + VB + 256; };
struct P { const bf16* Q; int qpitch; const bf16* K; int kpitch; const bf16* KR; const bf16* V; int vpitch; bf16* O; const int* pos; const float* invf;
           const float* subln; float lam_init; float lam; const float* kmax; int nblk; };
#define MFMA32(a, b, c) __builtin_amdgcn_mfma_f32_32x32x16_bf16((a), (b), (c), 0, 0, 0)
__device__ __forceinline__ int crow(int r, int hi) { return (r & 3) + 8 * (r >> 2) + 4 * hi; }
__device__ __forceinline__ bf16x8 pack_frag(const f32x16& p, int s) {
    u32x4 w; w.x = cvt_pk_bf16(p[8 * s + 0], p[8 * s + 1]); w.y = cvt_pk_bf16(p[8 * s + 2], p[8 * s + 3]); w.z = cvt_pk_bf16(p[8 * s + 4], p[8 * s + 5]); w.w = cvt_pk_bf16(p[8 * s + 6], p[8 * s + 7]);
    return __builtin_bit_cast(bf16x8, w);
}
__device__ __forceinline__ float max16(const f32x16& a) {
    float m0 = fmaxf(fmaxf(a[0], a[1]), fmaxf(a[2], a[3])), m1 = fmaxf(fmaxf(a[4], a[5]), fmaxf(a[6], a[7]));
    float m2 = fmaxf(fmaxf(a[8], a[9]), fmaxf(a[10], a[11])), m3 = fmaxf(fmaxf(a[12], a[13]), fmaxf(a[14], a[15]));
    return fmaxf(fmaxf(m0, m1), fmaxf(m2, m3));
}
__device__ __forceinline__ int imax16(const f32x16& a) {
#define FI(i) __float_as_int(a[i])
    const int m0 = max(max(FI(0), FI(1)), FI(2)), m1 = max(max(FI(3), FI(4)), FI(5)), m2 = max(max(FI(6), FI(7)), FI(8)), m3 = max(max(FI(9), FI(10)), FI(11)), m4 = max(max(FI(12), FI(13)), FI(14));
    return max(max(max(m0, m1), m2), max(max(m3, m4), FI(15)));
#undef FI
}
__device__ __forceinline__ float sum16(const f32x16& a) {
    return ((a[0] + a[1]) + (a[2] + a[3])) + ((a[4] + a[5]) + (a[6] + a[7])) + ((a[8] + a[9]) + (a[10] + a[11])) + ((a[12] + a[13]) + (a[14] + a[15]));
}
template <bool SUM> __device__ __forceinline__ bool softmax_tile(f32x16& pa, f32x16& pb, float& m, float& l, f32x16& o0, f32x16& o1, bool first) {
    float rm;
    if (first) { rm = fmaxf(max16(pa), max16(pb)); rm = fmaxf(rm, __shfl_xor(rm, 32)); }
    else { int im = max(imax16(pa), imax16(pb));
        const auto rr = __builtin_amdgcn_permlane32_swap((unsigned)im, (unsigned)im, false, false); im = max((int)rr[0], (int)rr[1]); rm = __int_as_float(im); }
    bool moved = false;
    if (first || __any(rm > 8.0f)) {
        asm volatile("" ::: "memory");
        const float dl = first ? rm : fmaxf(rm, 0.f); m += dl; moved = true;
        if (!first) { const float f = __builtin_amdgcn_exp2f(-dl); l *= f;
#pragma unroll
            for (int r = 0; r < 16; ++r) { o0[r] *= f; o1[r] *= f; } }
#pragma unroll
        for (int r = 0; r < 16; ++r) { pa[r] -= dl; pb[r] -= dl; }
    }
#pragma unroll
    for (int r = 0; r < 16; ++r) { pa[r] = __builtin_amdgcn_exp2f(pa[r]); pb[r] = __builtin_amdgcn_exp2f(pb[r]); }
    if (SUM) l += sum16(pa) + sum16(pb);
    return moved;
}

__device__ __forceinline__ void split3_bf16(float x, unsigned& h1, unsigned& h2, unsigned& h3) {
    h1 = cvt_pk_bf16(x, 0.f) & 0xffffu; const float r1 = x - bf_lo(h1); h2 = cvt_pk_bf16(r1, 0.f) & 0xffffu; const float r2 = r1 - bf_lo(h2); h3 = cvt_pk_bf16(r2, 0.f) & 0xffffu;
}
template <int MODE, bool FAST = false> __device__ __forceinline__ void attn_pass(LAS unsigned char* lds, const bf16x8 (&qr)[MODE == 0 ? 6 : 4], const bf16* kb_g, int kpitch, const bf16* kr_g,
                                                              const bf16* vb_g, int vpitch, const int* posb, float pqf, float slope2, float bq0, float bq1, int q0, int qrow, int w,
                                                              f32x16 (&o)[MODE == 0 ? 1 : 2][2], float (&l)[MODE == 0 ? 1 : 2]) {
    constexpr int NM = MODE == 0 ? 1 : 2, NQ = MODE == 0 ? 6 : 2, KP = (MODE == 0 ? 192 : 128) + 16, KB = 64 * KP, BUF = KB + VB + 256;
    int tid_l = threadIdx.x; asm volatile("" : "+v"(tid_l));
    const int tid = tid_l, lane = tid & 63, r32 = lane & 31, hi = lane >> 5;
    const int skey = tid >> 3, sch = tid & 7, skey2 = tid >> 2, sch2 = tid & 3;
    const GAS bf16* ksrc = (const GAS bf16*)(kb_g + (unsigned)(skey * kpitch + sch * 8));
    const GAS bf16* vsrc = (const GAS bf16*)(vb_g + (unsigned)(skey * SEQ + sch * 8));
    const GAS bf16* krsrc = (const GAS bf16*)(kr_g + (unsigned)(skey2 * 32 + sch2 * 8));
    const GAS int* posg = (const GAS int*)posb;
    u32x4 kreg, vreg, krreg = {0u, 0u, 0u, 0u}; float pkreg = 0.f;
    const int NT = (q0 + 256) / 64, ntw = (q0 + 32 * w) / 64 + 1;
    constexpr bool REV = (MODE == 1) && FAST;
    int wdone = 0;
#define ATT_LOAD(t) do { vreg = *(const GAS u32x4*)(vsrc + (unsigned)((t) * 64)); kreg = *(const GAS u32x4*)(ksrc + (unsigned)((t) * 64 * kpitch)); \
        if (MODE == 0) { if (tid < 256) krreg = *(const GAS u32x4*)(krsrc + (unsigned)((t) * 64 * 32)); } \
        else { if (tid < 64) pkreg = (float)posg[(t) * 64 + tid]; } } while (0)
#define ATT_STORE(bufi) do { LAS unsigned char* sb = lds + (bufi) * BUF; *(LAS u32x4*)(sb + skey * KP + sch * 16) = kreg; \
        if (MODE == 0) { if (tid < 256) *(LAS u32x4*)(sb + skey2 * KP + 128 + sch2 * 16) = krreg; } \
        else { if (tid < 64) *(LAS float*)(sb + KB + VB + tid * 4) = pkreg; } \
        LAS u32x2* vt = (LAS u32x2*)(sb + KB + skey * VP + sch * 16); vt[0] = (u32x2){vreg.x, vreg.y}; vt[1] = (u32x2){vreg.z, vreg.w}; } while (0)
    float m[NM];
    f32x16 negm, lsum;
#pragma unroll
    for (int r = 0; r < 16; ++r) { negm[r] = 0.f; lsum[r] = 0.f; }
#pragma unroll
    for (int i = 0; i < NM; ++i) { m[i] = 0.f; l[i] = (MODE == 0) ? 1.0f : 0.f;
#pragma unroll
        for (int r = 0; r < 16; ++r) { o[i][0][r] = 0.f; o[i][1][r] = 0.f; } }
    bf16x8 qx[2];
    if constexpr (MODE == 1 && FAST) { unsigned s1, s2, s3; split3_bf16(slope2, s1, s2, s3);
        const unsigned e1 = cvt_pk_bf16(bf_lo(s1) * 64.0f, bf_lo(s2) * 64.0f), e2 = (cvt_pk_bf16(bf_lo(s3) * 64.0f, 0.f) & 0xffffu) | (s1 << 16), e3 = s2 | (s3 << 16);
        const u32x4 qv = {hi ? 0u : e1, hi ? 0u : e2, hi ? 0u : e3, 0u}; qx[0] = __builtin_bit_cast(bf16x8, qv); qx[1] = qx[0]; }
    ATT_LOAD(REV ? NT - 1 : 0); ATT_STORE(0); __syncthreads();
    for (int it = 0; it < NT; ++it) {
        const int t = REV ? NT - 1 - it : it; const bool first_t = REV ? (t == ntw - 1) : (t == 0);
        if (it + 1 < NT) ATT_LOAD(REV ? t - 1 : t + 1);
        if (t < ntw && !wdone) {
            LAS unsigned char* bb = lds + (it & 1) * BUF;
            const LAS unsigned char* kb = bb + r32 * KP + 16 * hi;
            bf16x8 kf[NM][2][NQ];
            f32x16 dist[2];
            bf16x8 kx[2];
            if constexpr (MODE == 1 && !FAST) {
                const LAS float* pk = (const LAS float*)(bb + KB + VB);
#pragma unroll
                for (int hf = 0; hf < 2; ++hf)
#pragma unroll
                    for (int g = 0; g < 4; ++g) { const f32x4 pk4 = *(const LAS f32x4*)(pk + 32 * hf + 8 * g + 4 * hi);
#pragma unroll
                        for (int e = 0; e < 4; ++e) dist[hf][4 * g + e] = pqf - pk4[e]; }
            }
            if constexpr (MODE == 1 && FAST) {
                const LAS float* pk = (const LAS float*)(bb + KB + VB);
#pragma unroll
                for (int hf = 0; hf < 2; ++hf) { const float pv = pk[32 * hf + r32]; const float a = __builtin_floorf(pv * 0.015625f), bq = __builtin_fmaf(-64.0f, a, pv);
                    const unsigned aa = cvt_pk_bf16(a, a), ab = cvt_pk_bf16(a, bq), bb2 = cvt_pk_bf16(bq, bq);
                    const u32x4 kv = {hi ? 0x3f803f80u : aa, hi ? 0x00003f80u : ab, hi ? 0u : bb2, 0u}; kx[hf] = __builtin_bit_cast(bf16x8, kv); }
            }
            bf16x8 pf[NM][4];
#pragma unroll
            for (int mp = 0; mp < NM; ++mp) {
                f32x16 p[2];
#pragma unroll
                for (int hf = 0; hf < 2; ++hf)
#pragma unroll
                    for (int d = 0; d < NQ; ++d) kf[mp][hf][d] = *(const LAS bf16x8*)(kb + hf * 32 * KP + 32 * (mp * NQ + d));
                __builtin_amdgcn_sched_barrier(0);
                if constexpr (MODE == 1 && FAST) {
                    if (t == ntw - 1) {
                        int tt = t; asm volatile("" : "+s"(tt));
                        const float tb = (float)(qrow - 64 * tt - 4 * hi);
#pragma unroll
                        for (int hf = 0; hf < 2; ++hf) { f32x16 c;
#pragma unroll
                            for (int r = 0; r < 16; ++r) c[r] = fminf(tb - (float)(32 * hf + (r & 3) + 8 * (r >> 2)), 0.f) * 1e30f;
                            p[hf] = MFMA32(kx[hf], qx[mp], c); }
                    } else {
                        const f32x16 z16 = {0.f, 0.f, 0.f, 0.f, 0.f, 0.f, 0.f, 0.f, 0.f, 0.f, 0.f, 0.f, 0.f, 0.f, 0.f, 0.f};
#pragma unroll
                        for (int hf = 0; hf < 2; ++hf) p[hf] = MFMA32(kx[hf], qx[mp], z16);
                    }
#pragma unroll
                    for (int hf = 0; hf < 2; ++hf)
#pragma unroll
                        for (int d = 0; d < NQ; ++d) p[hf] = MFMA32(kf[mp][hf][d], qr[mp * NQ + d], p[hf]);
                } else if constexpr (MODE == 1) {
#pragma unroll
                    for (int hf = 0; hf < 2; ++hf)
#pragma unroll
                        for (int r = 0; r < 16; ++r) p[hf][r] = __builtin_fmaf(-slope2, __builtin_fabsf(dist[hf][r]), -m[mp]);
                    if (t == ntw - 1) {
                        int tt = t; asm volatile("" : "+s"(tt));
                        const float tb = (float)(qrow - 64 * tt - 4 * hi);
#pragma unroll
                        for (int hf = 0; hf < 2; ++hf)
#pragma unroll
                            for (int r = 0; r < 16; ++r) p[hf][r] += fminf(tb - (float)(32 * hf + (r & 3) + 8 * (r >> 2)), 0.f) * 1e30f;
                    }
#pragma unroll
                    for (int hf = 0; hf < 2; ++hf)
#pragma unroll
                        for (int d = 0; d < NQ; ++d) p[hf] = MFMA32(kf[mp][hf][d], qr[mp * NQ + d], p[hf]);
                } else {
                    if (t == ntw - 1) {
                        int tt = t; asm volatile("" : "+s"(tt));
                        const float tb = (float)(qrow - 64 * tt - 4 * hi);
#pragma unroll
                        for (int hf = 0; hf < 2; ++hf) { f32x16 c;
#pragma unroll
                            for (int r = 0; r < 16; ++r) c[r] = negm[r] + fminf(tb - (float)(32 * hf + (r & 3) + 8 * (r >> 2)), 0.f) * 1e30f;
                            p[hf] = MFMA32(kf[0][hf][0], qr[0], c); }
                    } else {
#pragma unroll
                        for (int hf = 0; hf < 2; ++hf) p[hf] = MFMA32(kf[0][hf][0], qr[0], negm);
                    }
#pragma unroll
                    for (int hf = 0; hf < 2; ++hf)
#pragma unroll
                        for (int d = 1; d < NQ; ++d) p[hf] = MFMA32(kf[0][hf][d], qr[d], p[hf]);
                }
                __builtin_amdgcn_sched_barrier(0);
                const float l_before = l[mp];
                const bool moved = softmax_tile<MODE == 1>(p[0], p[1], m[mp], l[mp], o[mp][0], o[mp][1], first_t);
                if constexpr (MODE == 1 && FAST) { if (moved) { unsigned h1, h2, h3; split3_bf16(-m[mp], h1, h2, h3);
                        if (hi) { const u32x4 qv = {h1 | (h2 << 16), h3, 0u, 0u}; qx[mp] = __builtin_bit_cast(bf16x8, qv); } } }
                if (MODE == 0 && moved) { const float f = first_t ? 0.f : l[0] / l_before;
#pragma unroll
                    for (int r = 0; r < 16; ++r) { negm[r] = -m[0]; lsum[r] *= f; } l[0] = 1.0f; }
#pragma unroll
                for (int ks = 0; ks < 4; ++ks) pf[mp][ks] = pack_frag(p[ks >> 1], ks & 1);
            }
            const LAS unsigned char* vb = bb + KB + r32 * VP + 8 * hi;
#pragma unroll
            for (int dh = 0; dh < 2; ++dh) {
                bf16x8 vf[4];
#pragma unroll
                for (int ks = 0; ks < 4; ++ks) {
                    const u32x2 v0 = *(const LAS u32x2*)(vb + dh * 32 * VP + 32 * ks), v1 = *(const LAS u32x2*)(vb + dh * 32 * VP + 32 * ks + 16);
                    const u32x4 vv = {v0.x, v0.y, v1.x, v1.y}; vf[ks] = __builtin_bit_cast(bf16x8, vv); }
                __builtin_amdgcn_sched_barrier(0);
#pragma unroll
                for (int ks = 0; ks < 4; ++ks)
#pragma unroll
                    for (int mp = 0; mp < NM; ++mp) o[mp][dh] = MFMA32(vf[ks], pf[mp][ks], o[mp][dh]);
                __builtin_amdgcn_sched_barrier(0);
            }
            if constexpr (MODE == 0) {
                const u32x4 o1 = {0x3f803f80u, 0x3f803f80u, 0x3f803f80u, 0x3f803f80u}; const bf16x8 ones = __builtin_bit_cast(bf16x8, o1);
#pragma unroll
                for (int ks = 0; ks < 4; ++ks) lsum = MFMA32(ones, pf[0][ks], lsum);
            }
        }
        if (it + 1 < NT) ATT_STORE((it + 1) & 1);
        if constexpr (REV) {
            if (!wdone && t <= ntw - 1 && t >= 1) { const float pkm = (float)posg[64 * (t - 1) + 63];
                const float v = fmaxf(bq0 - m[0], bq1 - m[NM - 1]) + slope2 * pkm; wdone = __all(v < -152.0f) ? 1 : 0; }
            if (__syncthreads_and(wdone)) break;
        } else __syncthreads();
    }
    if constexpr (MODE == 0) l[0] = 0.5f * lsum[0];
#undef ATT_LOAD
#undef ATT_STORE
}

template <int MODE, bool FAST = false> __device__ __forceinline__ void attn_unit(LAS unsigned char* lds, const P& A, int b, int h, int qb) {
    int tid_l = threadIdx.x; asm volatile("" : "+v"(tid_l));
    const int tid = tid_l, lane = tid & 63, r32 = lane & 31, hi = lane >> 5; const int w = __builtin_amdgcn_readfirstlane(tid >> 6);
    const int q0 = qb * 256, qrow = q0 + 32 * w + r32; const unsigned rowbase = (unsigned)b * SEQ;
    const float LOG2E = 1.4426950408889634f;
    f32x16 res[2];
    if constexpr (MODE == 0) {
        const float qscale = 0.10206207261596575f * LOG2E;
        bf16x8 qr[6];
        {
            const bf16* qs = A.Q + (size_t)(rowbase + qrow) * 768 + h * 96 + 8 * hi;
            u32x4 raw[6];
#pragma unroll
            for (int d0 = 0; d0 < 6; ++d0) raw[d0] = *(const u32x4*)(qs + 16 * d0);
            float x1[8], x2[8];
#pragma unroll
            for (int e = 0; e < 4; ++e) { x1[2 * e] = bf_lo(raw[4][e]); x1[2 * e + 1] = bf_hi(raw[4][e]); x2[2 * e] = bf_lo(raw[5][e]); x2[2 * e + 1] = bf_hi(raw[5][e]); }
            const float posf = (float)A.pos[rowbase + qrow];
#pragma unroll
            for (int e = 0; e < 8; ++e) { const float fq = A.invf[8 * hi + e]; float s, c; sincos_acc(posf * fq, s, c);
                const float a = x1[e], bb2 = x2[e]; x1[e] = (a * c - bb2 * s) * qscale; x2[e] = (bb2 * c + a * s) * qscale; }
#pragma unroll
            for (int d0 = 0; d0 < 4; ++d0) { u32x4 wv;
#pragma unroll
                for (int e = 0; e < 4; ++e) wv[e] = cvt_pk_bf16(bf_lo(raw[d0][e]) * qscale, bf_hi(raw[d0][e]) * qscale);
                qr[d0] = __builtin_bit_cast(bf16x8, wv); }
            u32x4 w4, w5;
#pragma unroll
            for (int e = 0; e < 4; ++e) { w4[e] = cvt_pk_bf16(x1[2 * e], x1[2 * e + 1]); w5[e] = cvt_pk_bf16(x2[2 * e], x2[2 * e + 1]); }
            qr[4] = __builtin_bit_cast(bf16x8, w4); qr[5] = __builtin_bit_cast(bf16x8, w5);
        }
        f32x16 o[1][2]; float l[1];
        attn_pass<0>(lds, qr, A.K + (size_t)rowbase * 512, 512, A.KR + (size_t)rowbase * 32, A.V + (size_t)(b * 8 + h) * 64 * SEQ, 0, nullptr, 0.f, 0.f, 0.f, 0.f, q0, qrow, w, o, l);
        const float inv = 1.0f / (l[0] + __shfl_xor(l[0], 32));
#pragma unroll
        for (int dh = 0; dh < 2; ++dh)
#pragma unroll
            for (int r = 0; r < 16; ++r) res[dh][r] = o[0][dh][r] * inv;
    } else {
        const float qscale = 0.17677669529663687f * LOG2E;
        const float pqf = (float)A.pos[rowbase + qrow], slope2 = __builtin_amdgcn_exp2f(-(float)(h + 1)) * LOG2E;
        const float lam = A.lam;
        bf16x8 qr[4];
        { const bf16* qs = A.Q + (size_t)(rowbase + qrow) * 1024 + h * 64 + 8 * hi;
#pragma unroll
          for (int d0 = 0; d0 < 4; ++d0) { const u32x4 raw = *(const u32x4*)(qs + 16 * d0); u32x4 wv;
#pragma unroll
              for (int e = 0; e < 4; ++e) wv[e] = cvt_pk_bf16(bf_lo(raw[e]) * qscale, bf_hi(raw[e]) * qscale);
              qr[d0] = __builtin_bit_cast(bf16x8, wv); } }
        float bq0 = 0.f, bq1 = 0.f;
        if constexpr (FAST) {
            float n0 = 0.f, n1 = 0.f;
#pragma unroll
            for (int d0 = 0; d0 < 4; ++d0) { const u32x4 qv = __builtin_bit_cast(u32x4, qr[d0]); float a = 0.f;
#pragma unroll
                for (int e = 0; e < 4; ++e) { const float x = bf_lo(qv[e]), y = bf_hi(qv[e]); a += x * x + y * y; }
                if (d0 < 2) n0 += a; else n1 += a; }
            n0 += __shfl_xor(n0, 32); n1 += __shfl_xor(n1, 32);
            float k0 = 0.f, k1 = 0.f; const float* km = A.kmax + (b * 16 + h * 2);
            for (int blk = lane; blk < A.nblk; blk += 64) { k0 = fmaxf(k0, km[blk * 32]); k1 = fmaxf(k1, km[blk * 32 + 1]); }
#pragma unroll
            for (int sft = 1; sft < 64; sft <<= 1) { k0 = fmaxf(k0, __shfl_xor(k0, sft)); k1 = fmaxf(k1, __shfl_xor(k1, sft)); }
            bq0 = 1.02f * sqrtf(n0 * k0) + 0.05f; bq1 = 1.02f * sqrtf(n1 * k1) + 0.05f;
        }
        f32x16 o[2][2]; float l[2];
        attn_pass<1, FAST>(lds, qr, A.K + (size_t)rowbase * 1024, 1024, nullptr, A.V + (size_t)(b * 8 + h) * 64 * SEQ, 0, A.pos + rowbase, pqf, slope2, bq0, bq1, q0, qrow, w, o, l);
        const float inv0 = 1.0f / (l[0] + __shfl_xor(l[0], 32)), inv1 = lam / (l[1] + __shfl_xor(l[1], 32));
        float ss = 0.f;
#pragma unroll
        for (int dh = 0; dh < 2; ++dh)
#pragma unroll
            for (int r = 0; r < 16; ++r) { const float v = o[0][dh][r] * inv0 - o[1][dh][r] * inv1; res[dh][r] = v; ss += v * v; }
        ss += __shfl_xor(ss, 32);
        const float rs = __builtin_amdgcn_rsqf(ss * (1.0f / 64.0f) + 1e-6f) * (1.0f - A.lam_init);
#pragma unroll
        for (int dh = 0; dh < 2; ++dh)
#pragma unroll
            for (int g = 0; g < 4; ++g) { const f32x4 sg = *(const f32x4*)(A.subln + 32 * dh + 8 * g + 4 * hi);
#pragma unroll
                for (int e = 0; e < 4; ++e) res[dh][4 * g + e] *= rs * sg[e]; }
    }
    bf16* orow = A.O + (size_t)(rowbase + qrow) * 512 + h * 64 + 4 * hi;
#pragma unroll
    for (int dh = 0; dh < 2; ++dh)
#pragma unroll
        for (int g = 0; g < 4; ++g) { u32x2 wv; wv.x = cvt_pk_bf16(res[dh][4 * g], res[dh][4 * g + 1]); wv.y = cvt_pk_bf16(res[dh][4 * g + 2], res[dh][4 * g + 3]);
            *(u32x2*)(orow + 32 * dh + 8 * g) = wv; }
}
}

#define XB_TMO      128
#define XB_XCNT(j)  (256  + 64 * (j))
#define XB_XSUB(j)  (1280 + 64 * (j))
#define XB_XGEN(j)  (2304 + 64 * (j))
#define XB_TOP      3328
#define XB_TOPGEN   3392
#define XCD_BAR_WORDS 3456
#define XB_SPIN_CAP (1u << 18)

__device__ __forceinline__ unsigned xb_ld(unsigned* p)              { return __hip_atomic_load(p, __ATOMIC_RELAXED, __HIP_MEMORY_SCOPE_AGENT); }
__device__ __forceinline__ unsigned xb_add(unsigned* p, unsigned v) { return __hip_atomic_fetch_add(p, v, __ATOMIC_RELAXED, __HIP_MEMORY_SCOPE_AGENT); }
__device__ __forceinline__ unsigned xb_xcc_id() { return (unsigned)__builtin_amdgcn_s_getreg((3 << 11) | 20) & 0xFu; }
#define XB_SPIN(cond, bar) do { unsigned _sp = 0; while (cond) { __builtin_amdgcn_s_sleep(1); \
    if ((++_sp & 255u) == 0u) { if (xb_ld(&(bar)[XB_TMO])) break; if (_sp > XB_SPIN_CAP) { atomicAdd(&(bar)[XB_TMO], 1u); break; } } } } while (0)

struct XcdBarrier {
    unsigned* bar; unsigned x;
    volatile LAS unsigned* st;
};

__device__ __forceinline__ XcdBarrier xcd_barrier_post(unsigned* bar, volatile LAS unsigned* st) {
    XcdBarrier b; b.bar = bar; b.x = xb_xcc_id(); b.st = st;
    if (threadIdx.x == 0) (void)xb_add(&bar[XB_XCNT(b.x)], 1u);
    return b;
}
__device__ __forceinline__ void xcd_barrier_complete(unsigned* bar, unsigned x, unsigned& nloc, unsigned& nx) {
    const unsigned G = gridDim.x * gridDim.y * gridDim.z;
    unsigned sum, cnt, mine, sp = 0u;
    for (;;) {
        sum = 0u; cnt = 0u; mine = 0u;
#pragma unroll
        for (unsigned j = 0; j < 16; ++j) { const unsigned c = xb_ld(&bar[XB_XCNT(j)]); sum += c; cnt += (c > 0u) ? 1u : 0u; mine = (j == x) ? c : mine; }
        if (sum == G) break;
        __builtin_amdgcn_s_sleep(1);
        if ((++sp & 255u) == 0u) { if (xb_ld(&bar[XB_TMO])) break; if (sp > XB_SPIN_CAP) { atomicAdd(&bar[XB_TMO], 1u); break; } }
    }
    nloc = mine > 0u ? mine : 1u; nx = cnt > 0u ? cnt : 1u;
}

__device__ __forceinline__ void xcd_barrier(const XcdBarrier& b) {
    asm volatile("s_waitcnt vmcnt(0)" ::: "memory");
    __syncthreads();
    if (threadIdx.x == 0) {
        unsigned* bar = b.bar;
        __builtin_amdgcn_s_waitcnt(0);
        unsigned nloc = b.st[0], nx = b.st[1];
        if (nloc == 0u) { xcd_barrier_complete(bar, b.x, nloc, nx); b.st[0] = nloc; b.st[1] = nx; }
        const unsigned old = xb_add(&bar[XB_XSUB(b.x)], 1u);
        const unsigned gen = old / nloc;
        if (old + 1u == (gen + 1u) * nloc) {
            __builtin_amdgcn_fence(__ATOMIC_RELEASE, "agent");
            asm volatile("s_waitcnt vmcnt(0)" ::: "memory");
            const unsigned og = xb_add(&bar[XB_TOP], 1u);
            const unsigned tg = og / nx;
            if (og + 1u == (tg + 1u) * nx) xb_add(&bar[XB_TOPGEN], 1u);
            else XB_SPIN(xb_ld(&bar[XB_TOPGEN]) == tg, bar);
            __builtin_amdgcn_fence(__ATOMIC_ACQUIRE, "agent");
            xb_add(&bar[XB_XGEN(b.x)], 1u);
            asm volatile("s_waitcnt vmcnt(0)" ::: "memory");
        } else {
            XB_SPIN(xb_ld(&bar[XB_XGEN(b.x)]) == gen, bar);
            __builtin_amdgcn_fence(__ATOMIC_ACQUIRE, "agent");
            asm volatile("s_waitcnt vmcnt(0)" ::: "memory");
        }
    }
    __syncthreads();
}
#ifndef ONLY
#define ONLY -1
#endif
#define EN(x) (ONLY < 0 || ONLY == (x))
__device__ __forceinline__ int opaque_i(int v) { asm volatile("" : "+s"(v)); return v; }
#define KL1 opaque_i(1024)
#define KL2 opaque_i(512)
#define KL3 opaque_i(256)
#define KL4 opaque_i(128)
#define KL5 opaque_i(DFF)
constexpr int PH_PER_LAYER = 11, N_PHASES = NLAYER * PH_PER_LAYER + 1;
__global__ void __launch_bounds__(NTHR) fwd_kernel(Args args) {
    extern __shared__ __attribute__((aligned(16))) unsigned char lds_raw[];
    LAS unsigned char* lds = (LAS unsigned char*)lds_raw;
    const int G0 = gridDim.x, bx0 = blockIdx.x;
    typedef const __attribute__((address_space(4))) Args KArgs;
    KArgs* const ap0 = (KArgs*)__builtin_amdgcn_kernarg_segment_ptr();
    unsigned char* const ws0 = args.ws;
    if (threadIdx.x < 2) ((volatile LAS unsigned*)(lds + LDS_MISC))[threadIdx.x] = 0u;
    __syncthreads();
    const bool use_bar = (args.ph_hi - args.ph_lo) > 1;
    XcdBarrier bar; bar.bar = (unsigned*)(ws0 + WS_BAR); bar.x = 0; bar.st = (volatile LAS unsigned*)(lds + LDS_MISC);
    if (use_bar) bar = xcd_barrier_post((unsigned*)(ws0 + WS_BAR), (volatile LAS unsigned*)(lds + LDS_MISC));
    const int lo = args.ph_lo, hi_ph = args.ph_hi;
    const bool multi = (hi_ph - lo) > 1;

    for (int ph = lo; ph < hi_ph; ++ph) {
        const int L = ph / PH_PER_LAYER, k = ph - L * PH_PER_LAYER;
        int tid = threadIdx.x; asm volatile("" : "+v"(tid)); const int lane = tid & 63, wave = __builtin_amdgcn_readfirstlane(tid >> 6);
        unsigned char* ws = ws0; asm volatile("" : "+s"(ws));
        int G = G0, bx = bx0; asm volatile("" : "+s"(G), "+s"(bx));
        const KArgs* ap = ap0; asm volatile("" : "+s"(ap));
        float* const ssq = (float*)(ws + WS_SSQ);   float* const hbuf = ap->out; bf16* const HB = (bf16*)(ws + WS_HB);
        const int vcu = (G % 8 == 0) ? (bx % 8) * (G / 8) + bx / 8 : bx;
        const int gw = vcu * NWAVES + wave, NGW = G * NWAVES;
        if (ph == N_PHASES - 1) {
            const float* gn = ap->in[26]; const float* sq = ssq + (size_t)(3 * NLAYER) * TT * 16;
            for (int row = gw; row < TT; row += NGW) {
                const float rs = __builtin_amdgcn_rsqf(pg8::row_ssq(sq, row) * (1.0f / DM) + 1e-6f);
                const u32x4* hr = (const u32x4*)(HB + (size_t)row * DM); f32x4* xr = (f32x4*)(hbuf + (size_t)row * DM);
#pragma unroll
                for (int j = 0; j < 2; ++j) { const u32x4 v = hr[lane + 64 * j]; const int c8 = (lane + 64 * j) * 2;
                    const f32x4 g0 = ((const f32x4*)gn)[c8], g1 = ((const f32x4*)gn)[c8 + 1];
                    xr[c8] = (f32x4){bf_lo(v.x), bf_hi(v.x), bf_lo(v.y), bf_hi(v.y)} * rs * g0; xr[c8 + 1] = (f32x4){bf_lo(v.z), bf_hi(v.z), bf_lo(v.w), bf_hi(v.w)} * rs * g1; }
            }
        } else if (k == 0 && EN(0)) {
            LAS float* scr = (LAS float*)(lds + wave * 16384);
            int base = 0;
            for (int f = 0; f < 2; ++f) {
                const float* nrm = ap->in[f ? 22 : 2] + (size_t)L * DM; bf16* Wgu = (bf16*)(ws + (f ? WS_WGU2 : WS_WGU1));
                conv_matrix<1>(ap->in[f ? 23 : 3] + (size_t)L * DM * DFF, DM, DFF, nrm, Wgu, base, gw, NGW, scr, lane);
                conv_matrix<2>(ap->in[f ? 24 : 4] + (size_t)L * DM * DFF, DM, DFF, nrm, Wgu, base, gw, NGW, scr, lane);
                conv_matrix<0>(ap->in[f ? 25 : 5] + (size_t)L * DFF * DM, DFF, DM, nullptr, (bf16*)(ws + (f ? WS_WD2 : WS_WD1)), base, gw, NGW, scr, lane);
            }
            conv_matrix<3>(ap->in[7] + (size_t)L * DM * 5536, DM, 5536, ap->in[6] + (size_t)L * DM, (bf16*)(ws + WS_WIN), base, gw, NGW, scr, lane);
            conv_matrix<0>(ap->in[9] + (size_t)L * 256 * 768, 256, 768, nullptr, (bf16*)(ws + WS_WUQ), base, gw, NGW, scr, lane);
            conv_matrix<0>(ap->in[11] + (size_t)L * 128 * 1024, 128, 1024, nullptr, (bf16*)(ws + WS_WUKV), base, gw, NGW, scr, lane);
            for (int i = 0; i < 3; ++i) conv_matrix<0>(ap->in[20] + ((size_t)L * 3 + i) * 512 * 1024, 512, 1024, nullptr, (bf16*)(ws + WS_WB) + (size_t)i * 1024 * 512, base, gw, NGW, scr, lane);
            conv_matrix<0>(ap->in[21] + (size_t)L * DM * DM, DM, DM, nullptr, (bf16*)(ws + WS_WOUT), base, gw, NGW, scr, lane);
            const int gt = bx * NTHR + tid, ngt = G * NTHR;
            if (L == 0 && gt == 0) {
#pragma unroll
                for (int i = 0; i < 16; ++i) ((float*)(ws + WS_TAB))[i] = ap->invf[i]; }
            if (L == 0) {
                const int* posv = (const int*)ap->in[1]; bool bad = false;
                for (int i = gt; i < TT; i += ngt) { const int pv = posv[i]; bad |= (pv < 0) | (pv >= 16384); if ((i & (SEQ - 1)) != 0) bad |= (posv[i - 1] > pv); }
                if (bad) *(volatile unsigned*)(ws + WS_POSFLAG) = 1u; }
            { const float* pool_w = ap->in[17] + (size_t)L * 4 * 128 * 128; bf16* Wpool = (bf16*)(ws + WS_WPOOL);
              for (int i = gt; i < 512 * 512; i += ngt) { const int n = i >> 9, kk = i & 511; float v = 0.f; if ((n >> 7) == (kk >> 7)) v = pool_w[(size_t)(n >> 7) * 16384 + (kk & 127) * 128 + (n & 127)]; Wpool[i] = (bf16)(cvt_pk_bf16(v, 0.f) & 0xffffu); } }
            for (int i = gt; i < 96 * 1024 / 8; i += ngt) ((u32x4*)((bf16*)(ws + WS_WIN) + (size_t)416 * 1024))[i] = (u32x4){0u, 0u, 0u, 0u};
            if (L == 0) {
                const float* x = ap->in[0];
                for (int row = gw; row < TT; row += NGW) {
                    const f32x4* xr = (const f32x4*)(x + (size_t)row * DM) + lane; float s = 0.f;
#pragma unroll
                    for (int j = 0; j < 4; ++j) { const f32x4 v = xr[64 * j]; s += (v.x * v.x + v.y * v.y) + (v.z * v.z + v.w * v.w);
                        u32x2 o; o.x = cvt_pk_bf16(v.x, v.y); o.y = cvt_pk_bf16(v.z, v.w); ((u32x2*)(HB + (size_t)row * DM))[lane + 64 * j] = o; }
                    s = wave_sum(s); if (lane < 16) ssq[(size_t)row * 16 + lane] = lane == 0 ? s : 0.f;
                }
            }
        } else if ((k == 1 || k == 9) && EN(1)) {
            pg8::Gemm g{HB, (const bf16*)(ws + (k == 1 ? WS_WGU1 : WS_WGU2)), TT, 2 * DFF, KL1}; pg8::StaticOrder S; S.init(TT, 2 * DFF, G, bx);
            pg8::Epi<1> E{}; E.O = (bf16*)(ws + WS_HID); E.ldc = DFF; E.ssq = ssq + (size_t)(3 * L + (k == 1 ? 0 : 2)) * TT * 16; E.inv_n = 1.0f / DM;
            pg8::gemm_phase<pg8::Epi<1>, pg8::StaticOrder, true, true>(lds, g, S, E);
        } else if ((k == 2 || k == 8 || k == 10) && EN(2)) {
            pg8::Gemm g{(const bf16*)(ws + (k == 8 ? WS_MB : WS_HID)), (const bf16*)(ws + (k == 2 ? WS_WD1 : (k == 8 ? WS_WOUT : WS_WD2))), TT, DM, k == 8 ? KL1 : KL5};
            pg8::StaticOrder S; S.init(TT, DM, G, bx);
            pg8::Epi<2> E{}; E.O = HB; E.ldc = DM; E.alpha = __uint_as_float((unsigned)__builtin_amdgcn_readfirstlane(k == 8 ? 0x3f800000 : 0x3f000000));
            E.ssq_out = ssq + (size_t)(3 * L + (k == 2 ? 1 : (k == 8 ? 2 : 3))) * TT * 16;
            pg8::gemm_phase<pg8::Epi<2>, pg8::StaticOrder, true, true>(lds, g, S, E);
        } else if (k == 3 && EN(3)) {
            pg8::Gemm g{HB, (const bf16*)(ws + WS_WIN), TT, 2560, KL1}; pg8::StaticOrder S; S.init(TT, 2560, G, bx);
            pg8::Epi<0> E{}; E.O = (bf16*)(ws + WS_Z1); E.ldc = 1024; E.O2 = (bf16*)(ws + WS_Z2); E.ldc2 = 1024; E.split = 1024; E.G = (const bf16*)(ws + WS_VTD); E.ssq = ssq + (size_t)(3 * L + 1) * TT * 16; E.inv_n = 1.0f / DM;
            pg8::gemm_phase<pg8::Epi<0>, pg8::StaticOrder, true, true>(lds, g, S, E);
        } else if (k == 5 && EN(5)) {
            { pg8::Gemm g{(const bf16*)(ws + WS_CQN), (const bf16*)(ws + WS_WUQ), TT, 768, KL3}; pg8::StaticOrder S; S.init(TT, 768, G, bx);
              pg8::Epi<6> E{}; E.O = (bf16*)(ws + WS_QM); E.ldc = 768; pg8::gemm_phase<pg8::Epi<6>, pg8::StaticOrder, true, true>(lds, g, S, E); }
            __syncthreads();
            { pg8::Gemm g{(const bf16*)(ws + WS_CKVN), (const bf16*)(ws + WS_WUKV), TT, 1024, KL4}; pg8::StaticOrder S; S.init(TT, 1024, G, bx);
              pg8::Epi<7> E{}; E.O = (bf16*)(ws + WS_KN); E.ldc = 512; E.O2 = (bf16*)(ws + WS_VTM); pg8::gemm_phase<pg8::Epi<7>, pg8::StaticOrder, true, true>(lds, g, S, E); }
            __syncthreads();
            { pg8::Gemm g{(const bf16*)(ws + WS_POOLED), (const bf16*)(ws + WS_WPOOL), TT, 512, KL2}; pg8::StaticOrder S; S.init(TT, 512, G, bx);
              pg8::Epi<3> E{}; E.O = (bf16*)(ws + WS_YPOOL); E.ldc = 512; E.bias = ap->in[18] + L * 512; E.scale = ap->in[19] + L * 512;
              pg8::gemm_phase<pg8::Epi<3>, pg8::StaticOrder, true, true>(lds, g, S, E); }
        } else if (k == 4 && EN(4)) {
            const bf16* Z1 = (const bf16*)(ws + WS_Z1); bf16* CQN = (bf16*)(ws + WS_CQN); bf16* CKVN = (bf16*)(ws + WS_CKVN); bf16* KR = (bf16*)(ws + WS_KR); bf16* PO = (bf16*)(ws + WS_POOLED);
            const float* q_norm = ap->in[8] + (size_t)L * 256; const float* kv_norm = ap->in[10] + (size_t)L * 128; const int* pos = (const int*)ap->in[1];
            float kmx0 = 0.f, kmx1 = 0.f;
            for (int t = gw; t < TT; t += NGW) {
                const bf16* zr = Z1 + (size_t)t * 1024;
                { const u32x4 kv = *(const u32x4*)((const bf16*)(ws + WS_Z2) + (size_t)t * 1024 + 512 + 8 * lane); float ss = 0.f;
#pragma unroll
                  for (int e = 0; e < 4; ++e) { const float x = bf_lo(kv[e]), y = bf_hi(kv[e]); ss += x * x + y * y; }
                  ss += __shfl_xor(ss, 1); ss += __shfl_xor(ss, 2);
                  if (t < SEQ) kmx0 = fmaxf(kmx0, ss); else kmx1 = fmaxf(kmx1, ss); }
                { const u32x2 v = ((const u32x2*)zr)[lane]; float x0 = bf_lo(v.x), x1 = bf_hi(v.x), x2 = bf_lo(v.y), x3 = bf_hi(v.y);
                  const float rs = __builtin_amdgcn_rsqf(wave_sum(x0 * x0 + x1 * x1 + x2 * x2 + x3 * x3) * (1.0f / 256.0f) + 1e-6f); const f32x4 gq = ((const f32x4*)q_norm)[lane];
                  u32x2 o; o.x = cvt_pk_bf16(x0 * rs * gq.x, x1 * rs * gq.y); o.y = cvt_pk_bf16(x2 * rs * gq.z, x3 * rs * gq.w); ((u32x2*)(CQN + (size_t)t * 256))[lane] = o; }
                { const unsigned v = ((const unsigned*)(zr + 256))[lane]; float x0 = bf_lo(v), x1 = bf_hi(v);
                  const float rs = __builtin_amdgcn_rsqf(wave_sum(x0 * x0 + x1 * x1) * (1.0f / 128.0f) + 1e-6f);
                  ((unsigned*)(CKVN + (size_t)t * 128))[lane] = cvt_pk_bf16(x0 * rs * kv_norm[2 * lane], x1 * rs * kv_norm[2 * lane + 1]); }
                if (lane < 16) { const float x1 = bf_lo((unsigned)zr[384 + lane]), x2 = bf_lo((unsigned)zr[400 + lane]); float s, c; sincos_acc((float)pos[t] * ((const float*)(ws + WS_TAB))[lane], s, c);
                  KR[(size_t)t * 32 + lane] = (bf16)(cvt_pk_bf16(x1 * c - x2 * s, 0.f) & 0xffffu); KR[(size_t)t * 32 + 16 + lane] = (bf16)(cvt_pk_bf16(x2 * c + x1 * s, 0.f) & 0xffffu); }
                { const int tp = t & (SEQ - 1), wdw = 2 << (lane >> 4), cnt = (tp + 1) < wdw ? (tp + 1) : wdw;
                  float a[8]; const u32x4 cur = *(const u32x4*)(zr + 512 + 8 * lane);
#pragma unroll
                  for (int e = 0; e < 4; ++e) { a[2 * e] = bf_lo(cur[e]); a[2 * e + 1] = bf_hi(cur[e]); }
                  float sm[8];
#pragma unroll
                  for (int e = 0; e < 8; ++e) sm[e] = a[e];
                  for (int j = 1; j < cnt; ++j) { const u32x4 pv = *(const u32x4*)(zr - (size_t)j * 1024 + 512 + 8 * lane);
#pragma unroll
                      for (int e = 0; e < 4; ++e) { sm[2 * e] += bf_lo(pv[e]); sm[2 * e + 1] += bf_hi(pv[e]); } }
                  const float ic = 1.0f / (float)cnt; u32x4 o;
#pragma unroll
                  for (int e = 0; e < 4; ++e) o[e] = cvt_pk_bf16(sm[2 * e] * ic - a[2 * e], sm[2 * e + 1] * ic - a[2 * e + 1]);
                  *(u32x4*)(PO + (size_t)t * 512 + 8 * lane) = o; }
            }
            {
                LAS float* red = (LAS float*)lds;
                if ((lane & 3) == 0) { red[(wave * 2 + 0) * 16 + (lane >> 2)] = kmx0; red[(wave * 2 + 1) * 16 + (lane >> 2)] = kmx1; }
                __syncthreads();
                if (tid < 32 && bx < 1024) { float mx = 0.f;
#pragma unroll
                    for (int wv = 0; wv < 8; ++wv) mx = fmaxf(mx, red[(wv * 2 + (tid >> 4)) * 16 + (tid & 15)]);
                    ((float*)(ws + WS_KMAX))[((size_t)L * 1024 + bx) * 32 + tid] = mx; }
                __syncthreads();
            }
        } else if (k == 6 && EN(6)) {
            const int* pos = (const int*)ap->in[1];
            float lam_u;
            { float a1 = lane < 32 ? ap->in[12][L * 32 + lane] * ap->in[13][L * 32 + lane] : 0.f, a2 = lane < 32 ? ap->in[14][L * 32 + lane] * ap->in[15][L * 32 + lane] : 0.f;
              a1 = wave_sum(a1); a2 = wave_sum(a2); const float lv = __expf(a1) - __expf(a2) + (L == 0 ? ap->lam_init[0] : ap->lam_init[1]);
              lam_u = __uint_as_float((unsigned)__builtin_amdgcn_readfirstlane((int)__float_as_uint(lv))); }
            const bool pos_generic = __builtin_amdgcn_readfirstlane((int)__hip_atomic_load((const unsigned*)(ws + WS_POSFLAG), __ATOMIC_RELAXED, __HIP_MEMORY_SCOPE_AGENT)) != 0 || G > 1024;
            {
                volatile LAS unsigned* qslot = (volatile LAS unsigned*)(lds + LDS_MISC + 64);
                unsigned* head = (unsigned*)(ws + WS_ATTQ + 64 * L);
                for (;;) {
                    if (tid == 0) *qslot = __hip_atomic_fetch_add(head, 1u, __ATOMIC_RELAXED, __HIP_MEMORY_SCOPE_AGENT);
                    __syncthreads();
                    const int idx = __builtin_amdgcn_readfirstlane((int)*qslot);
                    __syncthreads();
                    if (idx >= 1024) break;
                    const int code = ap->order[idx], type = code >> 9, b = (code >> 8) & 1, h = (code >> 5) & 7, qb = code & 31;
                    if (type == 0) {
#ifndef NO_ATT0
                        att::P A{}; A.Q = (const bf16*)(ws + WS_QM); A.qpitch = 768; A.K = (const bf16*)(ws + WS_KN) + h * 64; A.kpitch = 512; A.KR = (const bf16*)(ws + WS_KR);
                        A.V = (const bf16*)(ws + WS_VTM); A.vpitch = 0; A.O = (bf16*)(ws + WS_OM); A.pos = pos; A.invf = (const float*)(ws + WS_TAB);
                        att::attn_unit<0>(lds, A, b, h, qb);
#endif
                    } else {
#ifndef NO_ATT1
                        att::P A{}; A.Q = (const bf16*)(ws + WS_Z2); A.qpitch = 1024; A.K = (const bf16*)(ws + WS_Z2) + 512 + h * 64; A.kpitch = 1024; A.V = (const bf16*)(ws + WS_VTD); A.vpitch = 0;
                        A.O = (bf16*)(ws + WS_OD); A.pos = pos; A.subln = ap->in[16] + L * 64; A.lam = lam_u; A.kmax = (const float*)(ws + WS_KMAX) + (size_t)L * 1024 * 32; A.nblk = G;
                        A.lam_init = L == 0 ? ap->lam_init[0] : ap->lam_init[1];
                        if (pos_generic) att::attn_unit<1, false>(lds, A, b, h, qb); else att::attn_unit<1, true>(lds, A, b, h, qb);
#endif
                    }
                }
            }
        } else if (k == 7 && EN(7)) {
#pragma nounroll
            for (int i = 0; i < 3; ++i) {
                { pg8::Gemm g{HB, (const bf16*)(ws + WS_WG) + (size_t)i * 1024 * 1024, TT, 1024, KL1}; pg8::StaticOrder S; S.init(TT, 1024, G, bx);
                  pg8::Epi<4> E{}; E.O = (bf16*)(ws + WS_GT); E.ldc = 1024; E.ssq = ssq + (size_t)(3 * L + 1) * TT * 16; E.inv_n = 1.0f / DM; pg8::gemm_phase<pg8::Epi<4>, pg8::StaticOrder, true, true>(lds, g, S, E); }
                __syncthreads();
                { const bf16* Oi = (const bf16*)(ws + (i == 0 ? WS_OM : (i == 1 ? WS_OD : WS_YPOOL)));
                  pg8::Gemm g{Oi, (const bf16*)(ws + WS_WB) + (size_t)i * 1024 * 512, TT, 1024, KL2}; pg8::StaticOrder S; S.init(TT, 1024, G, bx);
                  pg8::Epi<5> E{}; E.O = (bf16*)(ws + WS_MB); E.ldc = 1024; E.G = (const bf16*)(ws + WS_GT); E.first = (i == 0); pg8::gemm_phase<pg8::Epi<5>, pg8::StaticOrder, true, true>(lds, g, S, E); }
                __syncthreads();
            }
        }
        if (multi && ph + 1 < hi_ph) { if (lo == 0x7fffff01) cg::this_grid().sync();   else xcd_barrier(bar); }
    }
}

#ifndef MK_PER_PHASE
#define MK_PER_PHASE 0
#endif
extern "C" void kernel_launch(void* const* d_in, const int* in_sizes, int n_in, void* d_out, int out_size, void* d_ws, size_t ws_size, hipStream_t stream) {
    static int grid = 0;
    if (grid == 0) {
        if (n_in != 27 || out_size != TT * DM || ws_size < WS_END) { fprintf(stderr, "kernel_launch: unexpected shapes (n_in %d out %d ws %zu)\n", n_in, out_size, ws_size); grid = -1; return; }
        int dev = 0, cus = 0, per_cu = 0;
        (void)hipGetDevice(&dev); (void)hipDeviceGetAttribute(&cus, hipDeviceAttributeMultiprocessorCount, dev);
        if (hipFuncSetAttribute((const void*)fwd_kernel, hipFuncAttributeMaxDynamicSharedMemorySize, LDS_BYTES) != hipSuccess) { fprintf(stderr, "kernel_launch: hipFuncSetAttribute failed\n"); grid = -1; return; }
        if (hipOccupancyMaxActiveBlocksPerMultiprocessor(&per_cu, (const void*)fwd_kernel, NTHR, LDS_BYTES) != hipSuccess || per_cu < 1) { fprintf(stderr, "kernel_launch: occupancy query says %d\n", per_cu); per_cu = 1; }
        (void)hipGetLastError();
        grid = cus * 1;
        fprintf(stderr, "kernel_launch: grid %d (cus %d, per_cu %d)\n", grid, cus, per_cu);
    }
    if (grid < 0) return;
    (void)hipMemsetAsync((char*)d_ws + WS_BAR, 0, BAR_ZERO_BYTES, stream);
    Args a{};
    for (int i = 0; i < 27; ++i) a.in[i] = (const float*)d_in[i];
    a.out = (float*)d_out; a.ws = (unsigned char*)d_ws;
    for (int i = 0; i < 16; ++i) a.invf[i] = (float)pow(10000.0, -(double)i / 16.0);
    for (int l = 0; l < 2; ++l) a.lam_init[l] = (float)(0.8 - 0.6 * exp(-0.3 * l));
    {
        static const int wcap[8] = {8, 12, 19, 33, 62, 120, 128, 128};
        struct U { float cost; unsigned short code; }; U us[1024]; int n = 0;
        for (int type = 0; type < 2; ++type) for (int b = 0; b < 2; ++b) for (int h = 0; h < 8; ++h) for (int qb = 0; qb < 32; ++qb) {
            const int nt = 4 * (qb + 1); float c;
            if (type == 0) c = 1.95f * nt + 3.0f; else { const int tt = nt < wcap[h] ? nt : wcap[h]; c = 3.1f * tt + 4.0f; }
            us[n].cost = c; us[n].code = (unsigned short)((type << 9) | (b << 8) | (h << 5) | qb); ++n; }
        for (int i = 1; i < 1024; ++i) { const U x = us[i]; int j = i - 1; while (j >= 0 && (us[j].cost < x.cost || (us[j].cost == x.cost && us[j].code > x.code))) { us[j + 1] = us[j]; --j; } us[j + 1] = x; }
        for (int i = 0; i < 1024; ++i) a.order[i] = us[i].code;
    }
#if MK_PER_PHASE
    for (int p = 0; p < N_PHASES; ++p) { a.ph_lo = p; a.ph_hi = p + 1; hipLaunchKernelGGL(fwd_kernel, dim3(grid), dim3(NTHR), LDS_BYTES, stream, a); }
#else
    a.ph_lo = 0; a.ph_hi = N_PHASES;
    void* kargs[] = {&a};
    hipError_t e = hipLaunchCooperativeKernel((const void*)fwd_kernel, dim3(grid), dim3(NTHR), kargs, LDS_BYTES, stream);
    if (e != hipSuccess) fprintf(stderr, "cooperative launch failed: %s (grid %d)\n", hipGetErrorString(e), grid);
#endif
}
```
